# Optimizing an MI355X kernel written in HIP

```python
import math
import jax, jax.numpy as jnp
from jax import lax
import numpy as np

D_MODEL = 2048
BATCH = 1
SEQ = 8192
DEPTH = 4

GRID_W = 64
CTX_LEN = 256
N_MIXERS = 3
HEAD_DIM = 128
GQA_HEADS = D_MODEL // HEAD_DIM
GQA_KV_HEADS = GQA_HEADS // 4
DIFF_HEAD_DIM = 128
DIFF_HEADS = D_MODEL // (2 * DIFF_HEAD_DIM)
FNET_GROUPS = 4
FNET_GROUP_DIM = D_MODEL // FNET_GROUPS
D_FF = 256 * math.ceil(8 * D_MODEL / 3 / 256)
CONV_WIDTH = 3
Q_BLOCK = 128
ROPE_THETA = 10000.0
EPS = 1e-6
ALPHA = (2 * DEPTH) ** 0.25
BETA = (8 * DEPTH) ** -0.25

kernel_name = 'hybrid_interleaved_dit_block'


def layer_norm(x, g, b):
    xf = x.astype(jnp.float32)
    xc = xf - jnp.mean(xf, axis=-1, keepdims=True)
    var = jnp.mean(xc * xc, axis=-1, keepdims=True)
    return (xc * lax.rsqrt(var + EPS) * g.astype(jnp.float32) + b.astype(jnp.float32)).astype(x.dtype)


def rms_norm(x, g):
    xf = x.astype(jnp.float32)
    ms = jnp.mean(xf * xf, axis=-1, keepdims=True)
    return (xf * lax.rsqrt(ms + EPS) * g.astype(jnp.float32)).astype(x.dtype)


def modulate(x, shift, scale):
    return x * (1 + scale) + shift


def axial_rope_cos_sin(row, col, head_dim):
    quarter = head_dim // 4
    inv_freq = ROPE_THETA ** (-jnp.arange(quarter, dtype=jnp.float32) / quarter)
    ang = jnp.concatenate([row.astype(jnp.float32)[:, None] * inv_freq[None, :],
                           col.astype(jnp.float32)[:, None] * inv_freq[None, :]], axis=-1)
    return jnp.cos(ang), jnp.sin(ang)


def apply_axial_rope(x, cos, sin):
    B, S, H, hd = x.shape
    q = hd // 4
    xf = x.astype(jnp.float32).reshape(B, S, H, 2, 2, q)
    x1, x2 = xf[..., 0, :], xf[..., 1, :]
    c = cos.reshape(1, S, 1, 2, q)
    s = sin.reshape(1, S, 1, 2, q)
    out = jnp.stack([x1 * c - x2 * s, x1 * s + x2 * c], axis=-2)
    return out.reshape(B, S, H, hd).astype(x.dtype)


def sweep_query_blocks(block_fn, q):
    B, S = q.shape[:2]
    nblk = S // Q_BLOCK
    qb = jnp.moveaxis(q.reshape(B, nblk, Q_BLOCK, *q.shape[2:]), 1, 0)
    out = lax.map(block_fn, qb)
    return jnp.moveaxis(out, 0, 1).reshape(B, S, *out.shape[3:])


def gqa_attend(q, k, v):
    B, Q = q.shape[:2]
    qg = q.reshape(B, Q, GQA_KV_HEADS, GQA_HEADS // GQA_KV_HEADS, HEAD_DIM)
    s = jnp.einsum('bqkgd,blkd->bkgql', qg, k).astype(jnp.float32) * (HEAD_DIM ** -0.5)
    p = jax.nn.softmax(s, axis=-1).astype(v.dtype)
    o = jnp.einsum('bkgql,blkd->bqkgd', p, v)
    return o.reshape(B, Q, GQA_HEADS * HEAD_DIM)


def gqa_mixer(h_lat, h_ctx, w_qkv, q_norm, k_norm, w_o, cos, sin, need_ctx):
    def project(h):
        B, L, _ = h.shape
        q, k, v = jnp.split(h @ w_qkv, [GQA_HEADS * HEAD_DIM, (GQA_HEADS + GQA_KV_HEADS) * HEAD_DIM], axis=-1)
        q = rms_norm(q.reshape(B, L, GQA_HEADS, HEAD_DIM), q_norm)
        k = rms_norm(k.reshape(B, L, GQA_KV_HEADS, HEAD_DIM), k_norm)
        return q, k, v.reshape(B, L, GQA_KV_HEADS, HEAD_DIM)

    q_l, k_l, v_l = project(h_lat)
    q_c, k_c, v_c = project(h_ctx)
    q_l = apply_axial_rope(q_l, cos, sin)
    k_l = apply_axial_rope(k_l, cos, sin)
    k_all = jnp.concatenate([k_l, k_c], axis=1)
    v_all = jnp.concatenate([v_l, v_c], axis=1)
    o_lat = sweep_query_blocks(lambda qb: gqa_attend(qb, k_all, v_all), q_l) @ w_o
    o_ctx = gqa_attend(q_c, k_c, v_c) @ w_o if need_ctx else None
    return o_lat, o_ctx


def diff_attend(q, k, v, lam, subln, lambda_init):
    B, Q = q.shape[:2]
    L = k.shape[1]
    q = q.reshape(B, Q, DIFF_HEADS, 2, DIFF_HEAD_DIM)
    k = k.reshape(B, L, DIFF_HEADS, 2, DIFF_HEAD_DIM)
    s = jnp.einsum('bqhcd,blhcd->bhcql', q, k).astype(jnp.float32) * (DIFF_HEAD_DIM ** -0.5)
    p = jax.nn.softmax(s, axis=-1)
    a = p[:, :, 0] - lam * p[:, :, 1]
    o = jnp.einsum('bhql,blhe->bqhe', a.astype(v.dtype), v)
    o = rms_norm(o, subln) * (1.0 - lambda_init)
    return o.reshape(B, Q, D_MODEL)


def diff_mixer(h_lat, h_ctx, w_qkv, lam_params, subln, w_o, cos, sin, lambda_init, need_ctx):
    def project(h):
        B, L, _ = h.shape
        q, k, v = jnp.split(h @ w_qkv, 3, axis=-1)
        return (q.reshape(B, L, 2 * DIFF_HEADS, DIFF_HEAD_DIM),
                k.reshape(B, L, 2 * DIFF_HEADS, DIFF_HEAD_DIM),
                v.reshape(B, L, DIFF_HEADS, 2 * DIFF_HEAD_DIM))

    lp = lam_params.astype(jnp.float32)
    lam = jnp.exp(jnp.sum(lp[0] * lp[1])) - jnp.exp(jnp.sum(lp[2] * lp[3])) + lambda_init
    q_l, k_l, v_l = project(h_lat)
    q_c, k_c, v_c = project(h_ctx)
    q_l = apply_axial_rope(q_l, cos, sin)
    k_l = apply_axial_rope(k_l, cos, sin)
    k_all = jnp.concatenate([k_l, k_c], axis=1)
    v_all = jnp.concatenate([v_l, v_c], axis=1)
    o_lat = sweep_query_blocks(lambda qb: diff_attend(qb, k_all, v_all, lam, subln, lambda_init), q_l) @ w_o
    o_ctx = diff_attend(q_c, k_c, v_c, lam, subln, lambda_init) @ w_o if need_ctx else None
    return o_lat, o_ctx


def fourier_mixer(h, w, b):
    B, L, _ = h.shape
    hg = h.astype(jnp.float32).reshape(B, L, FNET_GROUPS, FNET_GROUP_DIM)
    y = jnp.fft.fftn(hg, axes=(1, 3), norm='ortho').real
    return y.reshape(B, L, D_MODEL).astype(h.dtype) @ w + b


def conv_ffn(h, w_up, conv_w, conv_b, w_down):
    u = h @ w_up
    L = u.shape[1]
    pad = CONV_WIDTH // 2
    up = jnp.pad(u, ((0, 0), (pad, pad), (0, 0)))
    u = sum(conv_w[t] * up[:, t:t + L] for t in range(CONV_WIDTH)) + conv_b
    val, gate = jnp.split(u, 2, axis=-1)
    return (jax.nn.silu(gate) * val) @ w_down


def setup_inputs(seed: int = 0) -> dict:
    key = jax.random.key(seed)
    ks = iter(jax.random.split(key, 32))
    n_a = len(range(0, DEPTH, N_MIXERS))
    n_b = len(range(1, DEPTH, N_MIXERS))
    n_c = len(range(2, DEPTH, N_MIXERS))
    D = D_MODEL

    def normal(shape, scale=1.0):
        return jax.random.normal(next(ks), shape, jnp.float32) * scale

    def dense(shape, fan_in, gain=1.0):
        return normal(shape, gain * fan_in ** -0.5)

    def near_one(shape):
        return 1.0 + normal(shape, 0.02)

    return {
        'x': normal((BATCH, SEQ, D)),
        'c': normal((BATCH, D)),
        'ctx': normal((BATCH, CTX_LEN, D)),
        'c_ctx': normal((D,)),
        'ada_w': dense((DEPTH, D, 6 * D), D, 0.5),
        'ada_b': normal((DEPTH, 6 * D), 0.02),
        'ln_g': near_one((DEPTH, 2, D)),
        'ln_b': normal((DEPTH, 2, D), 0.02),
        'gqa_w_qkv': dense((n_a, D, (GQA_HEADS + 2 * GQA_KV_HEADS) * HEAD_DIM), D),
        'gqa_q_norm': near_one((n_a, HEAD_DIM)),
        'gqa_k_norm': near_one((n_a, HEAD_DIM)),
        'gqa_w_o': dense((n_a, D, D), D, BETA),
        'diff_w_qkv': dense((n_b, D, 3 * D), D),
        'diff_lambda': normal((n_b, 4, DIFF_HEAD_DIM), 0.1),
        'diff_subln': near_one((n_b, 2 * DIFF_HEAD_DIM)),
        'diff_w_o': dense((n_b, D, D), D, BETA),
        'fnet_w': dense((n_c, D, D), D, BETA),
        'fnet_b': normal((n_c, D), 0.02),
        'ffn_w_up': dense((DEPTH, D, 2 * D_FF), D),
        'ffn_conv_w': dense((DEPTH, CONV_WIDTH, 2 * D_FF), CONV_WIDTH),
        'ffn_conv_b': normal((DEPTH, 2 * D_FF), 0.02),
        'ffn_w_down': dense((DEPTH, D_FF, D), D_FF, BETA),
    }


def reference(x, c, ctx, c_ctx, ada_w, ada_b, ln_g, ln_b, gqa_w_qkv, gqa_q_norm, gqa_k_norm, gqa_w_o,
              diff_w_qkv, diff_lambda, diff_subln, diff_w_o, fnet_w, fnet_b,
              ffn_w_up, ffn_conv_w, ffn_conv_b, ffn_w_down):
    B, S, _ = x.shape
    ROWS = S // GRID_W
    row = jnp.repeat(jnp.arange(ROWS, dtype=jnp.int32), GRID_W)
    col = jnp.tile(jnp.arange(GRID_W, dtype=jnp.int32), ROWS)
    cos, sin = axial_rope_cos_sin(row, col, HEAD_DIM)

    x_l, x_c = x, ctx
    silu_c = jax.nn.silu(c)
    silu_cc = jax.nn.silu(c_ctx)
    counts = [0, 0, 0]
    for i in range(DEPTH):
        last = i == DEPTH - 1
        mod_l = jnp.split((silu_c @ ada_w[i] + ada_b[i])[:, None, :], 6, axis=-1)
        mod_c = jnp.split(silu_cc @ ada_w[i] + ada_b[i], 6, axis=-1)
        a_l = modulate(x_l, mod_l[0], mod_l[1])
        a_c = modulate(x_c, mod_c[0], mod_c[1])
        kind = i % N_MIXERS
        j = counts[kind]
        counts[kind] += 1
        if kind == 0:
            o_l, o_c = gqa_mixer(a_l, a_c, gqa_w_qkv[j], gqa_q_norm[j], gqa_k_norm[j], gqa_w_o[j],
                                 cos, sin, not last)
        elif kind == 1:
            lambda_init = 0.8 - 0.6 * math.exp(-0.3 * i)
            o_l, o_c = diff_mixer(a_l, a_c, diff_w_qkv[j], diff_lambda[j], diff_subln[j], diff_w_o[j],
                                  cos, sin, lambda_init, not last)
        else:
            o_l = fourier_mixer(a_l, fnet_w[j], fnet_b[j])
            o_c = None if last else fourier_mixer(a_c, fnet_w[j], fnet_b[j])
        x_l = layer_norm(ALPHA * x_l + mod_l[2] * o_l, ln_g[i, 0], ln_b[i, 0])
        f_l = conv_ffn(modulate(x_l, mod_l[3], mod_l[4]), ffn_w_up[i], ffn_conv_w[i], ffn_conv_b[i], ffn_w_down[i])
        x_l = layer_norm(ALPHA * x_l + mod_l[5] * f_l, ln_g[i, 1], ln_b[i, 1])
        if not last:
            x_c = layer_norm(ALPHA * x_c + mod_c[2] * o_c, ln_g[i, 0], ln_b[i, 0])
            f_c = conv_ffn(modulate(x_c, mod_c[3], mod_c[4]), ffn_w_up[i], ffn_conv_w[i], ffn_conv_b[i], ffn_w_down[i])
            x_c = layer_norm(ALPHA * x_c + mod_c[5] * f_c, ln_g[i, 1], ln_b[i, 1])
    return x_l
```

```cpp
#include <hip/hip_runtime.h>
#include <hip/hip_bf16.h>
#include <cstdio>
#include <cstdint>
#include <cmath>

#ifndef EN_FFN
#define EN_FFN 1
#endif
#ifndef EN_GQA
#define EN_GQA 1
#endif
#ifndef EN_DIFF
#define EN_DIFF 1
#endif
#ifndef EN_FNET
#define EN_FNET 1
#endif

constexpr int DM = 2048, SEQ = 8192, CTXL = 256, MROWS = SEQ + CTXL, DEPTH = 4, DFF = 5632, NUP = 2 * DFF;
constexpr int NMOD = 6 * DM;
constexpr float ALPHA_RES = 1.6817928305074292f;
constexpr float LN_EPS = 1e-6f;
constexpr int ZLD = 2 * SEQ + 2 * CTXL;

#define GAS __attribute__((address_space(1)))
#define LAS __attribute__((address_space(3)))
typedef unsigned short bf16_t;
typedef short bf16x8 __attribute__((ext_vector_type(8)));
typedef short s16x4 __attribute__((ext_vector_type(4)));
typedef float f32x4 __attribute__((ext_vector_type(4)));
typedef float f32x2 __attribute__((ext_vector_type(2)));
typedef float f32x16 __attribute__((ext_vector_type(16)));
typedef unsigned u32x4 __attribute__((ext_vector_type(4)));
typedef unsigned u32x2 __attribute__((ext_vector_type(2)));
typedef GAS unsigned gu32;

__device__ __forceinline__ unsigned cvt_pk_bf16(float lo, float hi) { unsigned r; asm volatile("v_cvt_pk_bf16_f32 %0, %1, %2" : "=v"(r) : "v"(lo), "v"(hi)); return r; }
__device__ __forceinline__ float bf_lo(unsigned u) { return __uint_as_float(u << 16); }
__device__ __forceinline__ float bf_hi(unsigned u) { return __uint_as_float(u & 0xffff0000u); }
__device__ __forceinline__ float wave_sum(float v) {
#pragma unroll
    for (int o = 1; o < 64; o <<= 1) v += __shfl_xor(v, o);
    return v;
}
__device__ __forceinline__ int opq_tid() { int t = threadIdx.x; asm volatile("" : "+v"(t)); return t; }
#define LDS_WAIT() asm volatile("s_waitcnt lgkmcnt(0)" ::: "memory")
#define VM_WAIT() asm volatile("s_waitcnt vmcnt(0)" ::: "memory")
#define RLX_AGENT __ATOMIC_RELAXED, __HIP_MEMORY_SCOPE_AGENT

constexpr size_t MiB = 1u << 20;
constexpr size_t WS_CTL = 0, CTL_ZERO_BYTES = 1 * MiB;
constexpr size_t WS_MODP = 1 * MiB;
constexpr size_t WS_MOD = 14 * MiB;
constexpr size_t WS_ROPE = 15 * MiB;
constexpr size_t WS_CS = 19 * MiB;
constexpr size_t WS_WQKV_G = 20 * MiB;
constexpr size_t WS_WO_G = 44 * MiB;
constexpr size_t WS_WQKV_D = 60 * MiB;
constexpr size_t WS_WO_D = 84 * MiB;
constexpr size_t WS_WF = 92 * MiB;
constexpr size_t WS_WUP = 100 * MiB;
constexpr size_t WS_WDN = 276 * MiB;
constexpr size_t WS_X = 364 * MiB;
constexpr size_t WS_OUTF = 430 * MiB;
constexpr size_t WS_ABF = 496 * MiB;
constexpr size_t WS_QKV = 529 * MiB;
constexpr size_t WS_OATT = 628 * MiB;
constexpr size_t WS_OBF = 694 * MiB;
constexpr size_t WS_U = 727 * MiB;
constexpr size_t WS_ACT = 909 * MiB;
constexpr size_t WS_ZT = 1000 * MiB;
constexpr size_t WS_A2 = 1066 * MiB;
constexpr size_t WS_END = 1339 * MiB;
constexpr int CW_BAR = 4096;

constexpr int RING_BYTES = 131072;
constexpr int LDSCTL_OFF = 139264;
constexpr int MISC_OFF = LDSCTL_OFF + 320;
constexpr int LDS_BYTES = 147456;
constexpr int NWAVES = 8;

#define XB_TMO      128
#define XB_XCNT(j)  (256  + 64 * (j))
#define XB_XSUB(j)  (1280 + 64 * (j))
#define XB_XGEN(j)  (2304 + 64 * (j))
#define XB_TOP      3328
#define XB_TOPGEN   3392
#define XCD_BAR_WORDS 3456
#define XB_SPIN_CAP (1u << 22)

__device__ __forceinline__ unsigned xb_ld(unsigned* p)              { return __hip_atomic_load(p, __ATOMIC_RELAXED, __HIP_MEMORY_SCOPE_AGENT); }
__device__ __forceinline__ unsigned xb_add(unsigned* p, unsigned v) { return __hip_atomic_fetch_add(p, v, __ATOMIC_RELAXED, __HIP_MEMORY_SCOPE_AGENT); }
__device__ __forceinline__ unsigned xb_xcc_id() { return (unsigned)__builtin_amdgcn_s_getreg((3 << 11) | 20) & 0xFu; }
#define XB_SPIN(cond, bar) do { unsigned _sp = 0; while (cond) { __builtin_amdgcn_s_sleep(1); \
    if ((++_sp & 255u) == 0u) { if (xb_ld(&(bar)[XB_TMO])) break; if (_sp > XB_SPIN_CAP) { atomicAdd(&(bar)[XB_TMO], 1u); break; } } } } while (0)

struct XcdBarrier { unsigned* bar; unsigned x; volatile LAS unsigned* st; };

__device__ __forceinline__ XcdBarrier xcd_barrier_post(unsigned* bar, volatile LAS unsigned* st) {
    XcdBarrier b; b.bar = bar; b.x = xb_xcc_id(); b.st = st;
    if (threadIdx.x == 0) (void)xb_add(&bar[XB_XCNT(b.x)], 1u);
    return b;
}
__device__ __forceinline__ void xcd_barrier_complete(unsigned* bar, unsigned x, unsigned& nloc, unsigned& nx) {
    const unsigned G = gridDim.x * gridDim.y * gridDim.z;
    unsigned sum, cnt, mine, sp = 0u;
    for (;;) {
        sum = 0u; cnt = 0u; mine = 0u;
#pragma unroll
        for (unsigned j = 0; j < 16; ++j) { const unsigned c = xb_ld(&bar[XB_XCNT(j)]); sum += c; cnt += (c > 0u) ? 1u : 0u; mine = (j == x) ? c : mine; }
        if (sum == G) break;
        __builtin_amdgcn_s_sleep(1);
        if ((++sp & 255u) == 0u) { if (xb_ld(&bar[XB_TMO])) break; if (sp > XB_SPIN_CAP) { atomicAdd(&bar[XB_TMO], 1u); break; } }
    }
    nloc = mine > 0u ? mine : 1u; nx = cnt > 0u ? cnt : 1u;
}
__device__ __forceinline__ void xcd_barrier(const XcdBarrier& b) {
    asm volatile("s_waitcnt vmcnt(0)" ::: "memory");
    __syncthreads();
    if (threadIdx.x == 0) {
        unsigned* bar = b.bar;
        __builtin_amdgcn_s_waitcnt(0);
        unsigned nloc = b.st[0], nx = b.st[1];
        if (nloc == 0u) { xcd_barrier_complete(bar, b.x, nloc, nx); b.st[0] = nloc; b.st[1] = nx; }
        const unsigned old = xb_add(&bar[XB_XSUB(b.x)], 1u);
        const unsigned gen = old / nloc;
        if (old + 1u == (gen + 1u) * nloc) {
            __builtin_amdgcn_fence(__ATOMIC_RELEASE, "agent");
            asm volatile("s_waitcnt vmcnt(0)" ::: "memory");
            const unsigned og = xb_add(&bar[XB_TOP], 1u);
            const unsigned tg = og / nx;
            if (og + 1u == (tg + 1u) * nx) xb_add(&bar[XB_TOPGEN], 1u);
            else XB_SPIN(xb_ld(&bar[XB_TOPGEN]) == tg, bar);
            __builtin_amdgcn_fence(__ATOMIC_ACQUIRE, "agent");
            xb_add(&bar[XB_XGEN(b.x)], 1u);
            asm volatile("s_waitcnt vmcnt(0)" ::: "memory");
        } else {
            XB_SPIN(xb_ld(&bar[XB_XGEN(b.x)]) == gen, bar);
            __builtin_amdgcn_fence(__ATOMIC_ACQUIRE, "agent");
            asm volatile("s_waitcnt vmcnt(0)" ::: "memory");
        }
    }
    __syncthreads();
}

namespace pg8 {
constexpr int BM = 256, BK = 64, HALF = 128, HTB = HALF * BK * 2, STAGE_BYTES = 8 * HTB, NXCD = 8, WGM = 8;
__host__ __device__ __forceinline__ int lds_byte(int r, int c) { const int st = (r >> 4) * 2 + (c >> 5), rr = r & 15, cc = c & 31, ob = rr * 64 + cc * 2; return st * 1024 + (ob ^ (((ob >> 9) & 1) << 5)); }
__host__ __device__ __forceinline__ void stage_rc(int b, int& R, int& C) { const int st = b / 1024, sb = b % 1024, swz = sb ^ (((sb >> 9) & 1) << 5); R = (st >> 1) * 16 + swz / 64; C = (st & 1) * 32 + (swz % 64) / 2; }
__host__ __device__ __forceinline__ int perm32(int rho) { const int n = rho >> 4, i = rho & 15; return 8 * (i >> 2) + 4 * n + (i & 3); }

struct Unit { const char* A; const char* B; int nt, orow, ocol; };

struct Sched {
    const char* A; const char* B; int lda, ldb, nM, nN, nt, mode, G, c;
    __device__ __forceinline__ bool next(int i, Unit& u) const {
        const int nwg = nM * nN; const long L = (long)i * G + c; if (L >= nwg) return false;
        if (mode == 2) {
            if (L < 256) { const int vc = ((int)L % 8) * 32 + (int)L / 8, pm = vc >> 3, pn = vc & 7;
                u.A = A + (size_t)pm * 256 * ZLD * 2; u.B = B + (size_t)pn * 256 * ZLD * 2; u.nt = 2 * SEQ / 64; u.orow = pm * 256; u.ocol = pn * 256; }
            else { const int pn = (int)L - 256;
                u.A = A + ((size_t)SEQ * ZLD + 2 * SEQ) * 2; u.B = B + ((size_t)pn * 256 * ZLD + 2 * SEQ) * 2; u.nt = 2 * CTXL / 64; u.orow = SEQ; u.ocol = pn * 256; }
            return true;
        }
        int wgid = (int)L; { const int q = nwg / NXCD, r = nwg % NXCD, xcd = wgid % NXCD, off = wgid / NXCD; wgid = (xcd < r ? xcd * (q + 1) : r * (q + 1) + (xcd - r) * q) + off; }
        const int nig = WGM * nN, gid = wgid / nig, fm = gid * WGM, gsz = (nM - fm) < WGM ? (nM - fm) : WGM;
        const int pm = fm + ((wgid % nig) % gsz), pn = (wgid % nig) / gsz;
        if (mode == 0) { u.A = A + (size_t)pm * 256 * lda * 2; u.B = B + (size_t)pn * 256 * ldb * 2; u.nt = nt; u.orow = pm * 256; u.ocol = pn * 256; }
        else {
            const int g = pm >> 2, trig = (pm >> 1) & 1, mb = pm & 1;
            u.A = A + (size_t)((trig * 2 + mb) * 256) * 512 * 2; u.B = B + ((size_t)pn * 256 * DM + 512 * g) * 2; u.nt = 8;
            u.orow = g * 512 + mb * 256; u.ocol = pn < 32 ? trig * SEQ + pn * 256 : 2 * SEQ + trig * CTXL;
        }
        return true;
    }
};

struct EpiBf16 {
    static constexpr bool PERM = true;
    bf16_t* O; int ldc;
    __device__ __forceinline__ void operator()(const f32x4 (&acc)[2][2][4][2], const Unit& u, int wr, int wc, int fr, int fq) const {
        bf16_t* base = O + (size_t)(u.orow + wr * 64 + fr) * ldc + u.ocol + wc * 32 + 8 * fq;
#pragma unroll
        for (int ai = 0; ai < 2; ++ai)
#pragma unroll
            for (int m = 0; m < 4; ++m) { bf16_t* rowp = base + (size_t)(ai * HALF + m * 16) * ldc;
#pragma unroll
                for (int bj = 0; bj < 2; ++bj) { const f32x4 v0 = acc[ai][bj][m][0], v1 = acc[ai][bj][m][1];
                    u32x4 w; w.x = cvt_pk_bf16(v0[0], v0[1]); w.y = cvt_pk_bf16(v0[2], v0[3]); w.z = cvt_pk_bf16(v1[0], v1[1]); w.w = cvt_pk_bf16(v1[2], v1[3]);
                    *(u32x4*)(rowp + bj * HALF) = w; } }
    }
};
struct EpiF32 {
    static constexpr bool PERM = false;
    float* C; int ldc; const float* bias;
    __device__ __forceinline__ void operator()(const f32x4 (&acc)[2][2][4][2], const Unit& u, int wr, int wc, int fr, int fq) const {
        const int col0 = u.ocol + wc * 32 + 4 * fq;
        f32x4 bv[2][2];
#pragma unroll
        for (int bj = 0; bj < 2; ++bj)
#pragma unroll
            for (int n = 0; n < 2; ++n) bv[bj][n] = bias ? *(const f32x4*)(bias + col0 + bj * HALF + n * 16) : (f32x4){0.f, 0.f, 0.f, 0.f};
#pragma unroll
        for (int ai = 0; ai < 2; ++ai)
#pragma unroll
            for (int m = 0; m < 4; ++m) { float* rowp = C + (size_t)(u.orow + wr * 64 + fr + ai * HALF + m * 16) * ldc + col0;
#pragma unroll
                for (int bj = 0; bj < 2; ++bj)
#pragma unroll
                    for (int n = 0; n < 2; ++n) *(f32x4*)(rowp + bj * HALF + n * 16) = acc[ai][bj][m][n] + bv[bj][n]; }
    }
};

template <class Epi, bool ALIGN_EPI>
__device__ __forceinline__ void gemm_phase(LAS unsigned char* lds, const Sched& S, const Epi& E) {
    const int tid = opq_tid(), wid = __builtin_amdgcn_readfirstlane(tid >> 6), lane = tid & 63, wr = wid >> 2, wc = wid & 3, fr = lane & 15, fq = lane >> 4;
    const int lda = S.lda, ldb = S.ldb;
    unsigned voffA[2], voffB[2];
#pragma unroll
    for (int i = 0; i < 2; ++i) { int R, C; stage_rc(tid * 16 + i * 8192, R, C); const int Rb = Epi::PERM ? ((R & ~31) + perm32(R & 31)) : R;
        voffA[i] = (unsigned)(R * lda + C) * 2u; voffB[i] = (unsigned)(Rb * ldb + C) * 2u; }
    const size_t kstep = (size_t)(BK * 2);
    const size_t hstepA = (size_t)HALF * lda * 2, hstepB = (size_t)HALF * ldb * 2;
    const unsigned ldsw = (unsigned)wid * 1024u;
    const int aoff = lds_byte(wr * 64 + fr, fq * 8), boff = lds_byte(wc * 32 + fr, fq * 8);
#define PG8_SA(b, h) (((b) * 2 + (h)) * HTB)
#define PG8_SB(b, h) ((4 + (b) * 2 + (h)) * HTB)
#define PG8_STAGE(bufoff, gbase, voff) do { _Pragma("unroll") for (int _i = 0; _i < 2; ++_i) \
        __builtin_amdgcn_global_load_lds((const unsigned*)((const char*)(gbase) + (voff)[_i]), (LAS unsigned*)(lds + (bufoff) + ldsw + _i * 8192), 16, 0, 0); } while (0)
#define PG8_LDA(dst, b, h) do { _Pragma("unroll") for (int m = 0; m < 4; ++m) _Pragma("unroll") for (int k = 0; k < 2; ++k) dst[m][k] = *(const LAS bf16x8*)(lds + PG8_SA(b, h) + aoff + m * 2048 + k * 1024); } while (0)
#define PG8_LDB(dst, b, h) do { _Pragma("unroll") for (int n = 0; n < 2; ++n) _Pragma("unroll") for (int k = 0; k < 2; ++k) dst[n][k] = *(const LAS bf16x8*)(lds + PG8_SB(b, h) + boff + n * 2048 + k * 1024); } while (0)
#define PG8_MMA(ai, bj, At, Bt) do { __builtin_amdgcn_s_setprio(1); _Pragma("unroll") for (int m = 0; m < 4; ++m) _Pragma("unroll") for (int n = 0; n < 2; ++n) _Pragma("unroll") for (int k = 0; k < 2; ++k) \
        acc[ai][bj][m][n] = __builtin_amdgcn_mfma_f32_16x16x32_bf16(Bt[n][k], At[m][k], acc[ai][bj][m][n], 0, 0, 0); __builtin_amdgcn_s_setprio(0); } while (0)
#define PG8_WAIT_V(n) asm volatile("s_waitcnt vmcnt(" #n ")" ::: "memory")
#define PG8_WAIT_L(n) asm volatile("s_waitcnt lgkmcnt(" #n ")" ::: "memory")
#define PG8_BAR __builtin_amdgcn_s_barrier()
#define PG8_SCHED __builtin_amdgcn_sched_barrier(0)
    Unit cur, nxt; int ui = 0;
    if (!S.next(0, cur)) return;
    f32x4 acc[2][2][4][2];
#pragma unroll
    for (int a = 0; a < 2; ++a)
#pragma unroll
        for (int b = 0; b < 2; ++b)
#pragma unroll
            for (int m = 0; m < 4; ++m)
#pragma unroll
                for (int n = 0; n < 2; ++n) acc[a][b][m][n] = (f32x4){0.f, 0.f, 0.f, 0.f};
    bf16x8 At[4][2], B0[2][2], B1[2][2];
    const char* cA = cur.A; const char* cB = cur.B;
    PG8_STAGE(PG8_SB(0, 0), cB, voffB); PG8_STAGE(PG8_SB(0, 1), cB + hstepB, voffB); PG8_STAGE(PG8_SA(0, 0), cA, voffA); PG8_STAGE(PG8_SA(0, 1), cA + hstepA, voffA);
    if (wr == 1) PG8_BAR;
    PG8_WAIT_V(2); PG8_BAR;
    PG8_STAGE(PG8_SB(1, 0), cB + kstep, voffB); PG8_STAGE(PG8_SA(1, 0), cA + kstep, voffA); PG8_STAGE(PG8_SB(1, 1), cB + hstepB + kstep, voffB);
    PG8_WAIT_V(6); PG8_BAR;
    for (;;) {
        const bool has_next = S.next(ui + 1, nxt);
        const char* nA = has_next ? nxt.A : cA; const char* nB = has_next ? nxt.B : cB;
        const int nt = cur.nt;
        for (int t = 0; t < nt; t += 2) {
            const bool last = (t == nt - 2);
            const char* a1 = cA + (size_t)(t + 1) * kstep;
            const char* a2 = last ? nA : cA + (size_t)(t + 2) * kstep; const char* b2 = last ? nB : cB + (size_t)(t + 2) * kstep;
            const char* a3 = a2 + kstep; const char* b3 = b2 + kstep;
            PG8_LDB(B0, 0, 0); PG8_LDB(B1, 0, 1); PG8_SCHED; PG8_LDA(At, 0, 0); PG8_STAGE(PG8_SA(1, 1), a1 + hstepA, voffA);
            PG8_WAIT_V(8); PG8_WAIT_L(0); PG8_BAR; PG8_MMA(0, 0, At, B0); PG8_MMA(0, 1, At, B1); PG8_BAR; PG8_SCHED;
            PG8_LDA(At, 0, 1); PG8_STAGE(PG8_SB(0, 0), b2, voffB); PG8_STAGE(PG8_SB(0, 1), b2 + hstepB, voffB); PG8_STAGE(PG8_SA(0, 0), a2, voffA);
            PG8_WAIT_V(8); PG8_WAIT_L(0); PG8_BAR; PG8_MMA(1, 0, At, B0); PG8_MMA(1, 1, At, B1); PG8_BAR; PG8_SCHED;
            PG8_LDB(B0, 1, 0); PG8_LDB(B1, 1, 1); PG8_SCHED; PG8_LDA(At, 1, 0); PG8_STAGE(PG8_SA(0, 1), a2 + hstepA, voffA);
            PG8_WAIT_V(8); PG8_WAIT_L(0); PG8_BAR; PG8_MMA(0, 0, At, B0); PG8_MMA(0, 1, At, B1); PG8_BAR; PG8_SCHED;
            PG8_LDA(At, 1, 1); PG8_STAGE(PG8_SB(1, 0), b3, voffB); PG8_STAGE(PG8_SB(1, 1), b3 + hstepB, voffB); PG8_STAGE(PG8_SA(1, 0), a3, voffA);
            PG8_WAIT_V(8); PG8_WAIT_L(0); PG8_BAR; PG8_MMA(1, 0, At, B0); PG8_MMA(1, 1, At, B1); PG8_BAR; PG8_SCHED;
        }
        if constexpr (ALIGN_EPI) { if (wr == 0) PG8_BAR; }
        E(acc, cur, wr, wc, fr, fq);
        if (!has_next) break;
#pragma unroll
        for (int a = 0; a < 2; ++a)
#pragma unroll
            for (int b = 0; b < 2; ++b)
#pragma unroll
                for (int m = 0; m < 4; ++m)
#pragma unroll
                    for (int n = 0; n < 2; ++n) acc[a][b][m][n] = (f32x4){0.f, 0.f, 0.f, 0.f};
        cur = nxt; cA = nA; cB = nB; ++ui;
        if constexpr (ALIGN_EPI) { if (wr == 1) PG8_BAR; }
    }
    PG8_WAIT_V(0);
    if constexpr (!ALIGN_EPI) { if (wr == 0) PG8_BAR; }
    PG8_BAR;
#undef PG8_SA
#undef PG8_SB
#undef PG8_STAGE
#undef PG8_LDA
#undef PG8_LDB
#undef PG8_MMA
#undef PG8_WAIT_V
#undef PG8_WAIT_L
#undef PG8_BAR
#undef PG8_SCHED
}
}

namespace att {
constexpr int D = 128, NW = 8, QBLK = 32, KVBLK = 64;
constexpr float SCALE = 0.088388347648318440f;
constexpr float THR = 8.f;
constexpr size_t SHM_V = KVBLK * D * 2, SHM_K = KVBLK * D * 2, SHM_ATTN = 2 * SHM_V + 2 * SHM_K + NW * 64 * 4;
#define KSWZ(row, colB) ((row) * 256 + ((colB) ^ (((row) & 7) << 4)))
#define SBAR() __builtin_amdgcn_sched_barrier(0)
__device__ __forceinline__ int crow(int r, int hi) { return (r & 3) + 8 * (r >> 2) + 4 * hi; }
__device__ __forceinline__ void partialSM(f32x16& p0, f32x16& p1, float& m_reg, float& mn, float& alpha) {
  constexpr float C = SCALE * 1.4426950408889634f;
  float pmax = p0[0]; for (int r = 1; r < 16; ++r) pmax = fmaxf(pmax, p0[r]); for (int r = 0; r < 16; ++r) pmax = fmaxf(pmax, p1[r]);
  { auto rr = __builtin_amdgcn_permlane32_swap(__float_as_uint(pmax), __float_as_uint(pmax), false, false);
    pmax = fmaxf(__uint_as_float(rr[0]), __uint_as_float(rr[1])); }
  if (__builtin_expect(__all(pmax - m_reg <= THR / SCALE), 1)) { mn = m_reg; alpha = 1.f; }
  else { mn = fmaxf(m_reg, pmax); alpha = __builtin_amdgcn_exp2f((m_reg - mn) * C); m_reg = mn; }
  float mnC = -mn * C;
  for (int r = 0; r < 16; ++r) p0[r] = fmaf(p0[r], C, mnC); for (int r = 0; r < 16; ++r) p1[r] = fmaf(p1[r], C, mnC);
  for (int r = 0; r < 16; ++r) p0[r] = __builtin_amdgcn_exp2f(p0[r]);
}
__device__ __forceinline__ void finishSM(f32x16& p0, f32x16& p1, float alpha, float& l_reg, bf16x8& pa0, bf16x8& pa1, bf16x8& pa2, bf16x8& pa3) {
  for (int r = 0; r < 16; ++r) p1[r] = __builtin_amdgcn_exp2f(p1[r]);
  float ps = 0; for (int r = 0; r < 16; ++r) ps += p0[r]; for (int r = 0; r < 16; ++r) ps += p1[r];
  { auto rr = __builtin_amdgcn_permlane32_swap(__float_as_uint(ps), __float_as_uint(ps), false, false);
    ps = __uint_as_float(rr[0]) + __uint_as_float(rr[1]); }
  l_reg = l_reg * alpha + ps;
#define PK4(P, BASE, OUT) do { unsigned a0 = cvt_pk_bf16(P[BASE + 0], P[BASE + 1]), a1 = cvt_pk_bf16(P[BASE + 2], P[BASE + 3]);   \
    unsigned b0 = cvt_pk_bf16(P[BASE + 4], P[BASE + 5]), b1 = cvt_pk_bf16(P[BASE + 6], P[BASE + 7]);                              \
    auto r0 = __builtin_amdgcn_permlane32_swap(a0, b0, false, false); auto r1 = __builtin_amdgcn_permlane32_swap(a1, b1, false, false); \
    u32x4 w = {r0[0], r1[0], r0[1], r1[1]}; OUT = *reinterpret_cast<bf16x8*>(&w); } while (0)
  PK4(p0, 0, pa0); PK4(p0, 8, pa1); PK4(p1, 0, pa2); PK4(p1, 8, pa3);
#undef PK4
}
__device__ __forceinline__ void qkt(f32x16& p0, f32x16& p1, const bf16_t* Ks, const bf16x8* qr, int r32, int hi) {
  p0 = f32x16{}; p1 = f32x16{};
  for (int d0 = 0; d0 < 8; ++d0) { int cb = (d0 * 16 + hi * 8) * 2;
    bf16x8 b0 = *reinterpret_cast<const bf16x8*>((const char*)Ks + KSWZ(r32, cb));
    bf16x8 b1 = *reinterpret_cast<const bf16x8*>((const char*)Ks + KSWZ(32 + r32, cb));
    p0 = __builtin_amdgcn_mfma_f32_32x32x16_bf16(b0, qr[d0], p0, 0, 0, 0);
    p1 = __builtin_amdgcn_mfma_f32_32x32x16_bf16(b1, qr[d0], p1, 0, 0, 0); }
}
__device__ __forceinline__ int v_st(int k, int c) { const int kk = (k & ~0xC) | ((k & 4) << 1) | ((k & 8) >> 1); return ((kk >> 3) * 4 + (c >> 5)) * 512 + ((kk & 7) * 32 + (c & 31)) * 2; }
__device__ __forceinline__ int v_rd_base(int lane) { return ((lane & 3) << 3) | (((lane >> 2) & 3) << 6) | (((lane >> 4) & 1) << 5) | (((lane >> 5) & 1) << 8); }
constexpr int v_rd_off(int d0, int ks, int half) { return d0 * 512 + ks * 4096 + half * 2048; }
template <int OFF> __device__ __forceinline__ s16x4 tr_read(int vb) {
  s16x4 r; asm volatile("ds_read_b64_tr_b16 %0, %1 offset:%2" : "=&v"(r) : "v"(vb), "i"(OFF) : "memory"); return r;
}
template <int D0> __device__ __forceinline__ void pv_one(f32x16& od, int vb, bf16x8 pa0, bf16x8 pa1, bf16x8 pa2, bf16x8 pa3) {
  const s16x4 l0 = tr_read<v_rd_off(D0, 0, 0)>(vb), h0 = tr_read<v_rd_off(D0, 0, 1)>(vb), l1 = tr_read<v_rd_off(D0, 1, 0)>(vb), h1 = tr_read<v_rd_off(D0, 1, 1)>(vb);
  const s16x4 l2 = tr_read<v_rd_off(D0, 2, 0)>(vb), h2 = tr_read<v_rd_off(D0, 2, 1)>(vb), l3 = tr_read<v_rd_off(D0, 3, 0)>(vb), h3 = tr_read<v_rd_off(D0, 3, 1)>(vb);
  asm volatile("s_waitcnt lgkmcnt(0)" ::: "memory"); SBAR();
#define PK(L, H) (bf16x8){L[0], L[1], L[2], L[3], H[0], H[1], H[2], H[3]}
  od = __builtin_amdgcn_mfma_f32_32x32x16_bf16(pa0, PK(l0, h0), od, 0, 0, 0);
  od = __builtin_amdgcn_mfma_f32_32x32x16_bf16(pa1, PK(l1, h1), od, 0, 0, 0);
  od = __builtin_amdgcn_mfma_f32_32x32x16_bf16(pa2, PK(l2, h2), od, 0, 0, 0);
  od = __builtin_amdgcn_mfma_f32_32x32x16_bf16(pa3, PK(l3, h3), od, 0, 0, 0);
#undef PK
}
__device__ __forceinline__ void pv_d0(f32x16* o, int vb, bf16x8 pa0, bf16x8 pa1, bf16x8 pa2, bf16x8 pa3) {
  pv_one<0>(o[0], vb, pa0, pa1, pa2, pa3); pv_one<1>(o[1], vb, pa0, pa1, pa2, pa3); pv_one<2>(o[2], vb, pa0, pa1, pa2, pa3); pv_one<3>(o[3], vb, pa0, pa1, pa2, pa3);
}
__device__ __forceinline__ void attn_unit(const bf16_t* __restrict__ Qb, int ldq, const bf16_t* __restrict__ Kh, const bf16_t* __restrict__ Vh, int ldk,
                                          bf16_t* __restrict__ Ob, int ldo, int seq, char* lds) {
  const int tid = opq_tid(), wid = tid >> 6, lane = tid & 63, r32 = lane & 31, hi = lane >> 5;
  bf16_t* V_lds = (bf16_t*)lds; bf16_t* K_lds = (bf16_t*)(lds + 2 * SHM_V);
  float* ws = (float*)(lds + 2 * SHM_V + 2 * SHM_K) + wid * 64; float* li_l = ws; float* al_l = ws + 32;
  float m_reg = -1e30f, l_reg = 0; f32x16 o[4] = {}; bf16x8 qr[8];
  const bf16_t* Qw = Qb + (long)(wid * QBLK + r32) * ldq + hi * 8;
#pragma unroll
  for (int d0 = 0; d0 < 8; ++d0) qr[d0] = *reinterpret_cast<const bf16x8*>(Qw + d0 * 16);
  const int sr = tid >> 4, sc = (tid & 15) * 8, vst0 = v_st(sr, sc), vst1 = v_st(32 + sr, sc);
  const int vb0 = (int)(uintptr_t)V_lds + v_rd_base(lane);
  struct { bf16x8 vs0, vs1, ks0, ks1; } sr_[2];
  const bf16_t* Vp = Vh + (long)sr * ldk + sc; const bf16_t* Kp = Kh + (long)sr * ldk + sc; const long r32s = 32L * ldk;
#define SLOAD(i, k0) do { const long ko_ = (long)(k0) * ldk; sr_[i].vs0 = *reinterpret_cast<const bf16x8*>(Vp + ko_); sr_[i].vs1 = *reinterpret_cast<const bf16x8*>(Vp + ko_ + r32s); \
    sr_[i].ks0 = *reinterpret_cast<const bf16x8*>(Kp + ko_); sr_[i].ks1 = *reinterpret_cast<const bf16x8*>(Kp + ko_ + r32s); } while (0)
#define SWRITE(b, i) do { *(bf16x8*)((char*)V_lds + (b) * SHM_V + vst0) = sr_[i].vs0;          \
    *(bf16x8*)((char*)V_lds + (b) * SHM_V + vst1) = sr_[i].vs1; int kc = sc * 2;               \
    *(bf16x8*)((char*)K_lds + (b) * SHM_K + KSWZ(sr, kc)) = sr_[i].ks0;                       \
    *(bf16x8*)((char*)K_lds + (b) * SHM_K + KSWZ(32 + sr, kc)) = sr_[i].ks1; } while (0)
#define SWAIT() asm volatile("s_waitcnt vmcnt(4)" ::: "memory")
#define RESC(a) do { if (__any((a) < 1.f)) { if (hi == 0) al_l[r32] = (a); asm volatile("s_waitcnt lgkmcnt(0)" ::: "memory"); \
    for (int d = 0; d < 4; ++d) for (int r = 0; r < 16; ++r) o[d][r] *= al_l[crow(r, hi)]; } } while (0)
  f32x16 pA0, pA1, pB0, pB1; float mnA, mnB, alA, alB; bf16x8 pa0, pa1, pa2, pa3; const int NT = seq / KVBLK;
  constexpr int SE = 0, SO = 1;
  SLOAD(SE, 0); asm volatile("s_waitcnt vmcnt(0)" ::: "memory"); SWRITE(0, SE); __syncthreads();
  qkt(pA0, pA1, K_lds, qr, r32, hi); partialSM(pA0, pA1, m_reg, mnA, alA);
  SLOAD(SO, KVBLK); if (2 < NT) SLOAD(SE, 2 * KVBLK);
  SWAIT(); SWRITE(1, SO); __syncthreads();
  for (int j = 1; j + 1 < NT; j += 2) {
    SBAR(); qkt(pB0, pB1, (bf16_t*)((char*)K_lds + SHM_K), qr, r32, hi);
    finishSM(pA0, pA1, alA, l_reg, pa0, pa1, pa2, pa3); SBAR();
    SLOAD(SO, (j + 2) * KVBLK); SBAR();
    pv_d0(o, vb0, pa0, pa1, pa2, pa3); partialSM(pB0, pB1, m_reg, mnB, alB);
    __syncthreads(); SWAIT(); SWRITE(0, SE);
    RESC(alB); __syncthreads();
    SBAR(); qkt(pA0, pA1, K_lds, qr, r32, hi);
    finishSM(pB0, pB1, alB, l_reg, pa0, pa1, pa2, pa3); SBAR();
    if (j + 3 < NT) SLOAD(SE, (j + 3) * KVBLK); SBAR();
    pv_d0(o, vb0 + (int)SHM_V, pa0, pa1, pa2, pa3); partialSM(pA0, pA1, m_reg, mnA, alA);
    __syncthreads(); SWAIT(); SWRITE(1, SO);
    RESC(alA); __syncthreads();
  }
  SBAR(); qkt(pB0, pB1, (bf16_t*)((char*)K_lds + SHM_K), qr, r32, hi);
  finishSM(pA0, pA1, alA, l_reg, pa0, pa1, pa2, pa3); SBAR();
  pv_d0(o, vb0, pa0, pa1, pa2, pa3); partialSM(pB0, pB1, m_reg, mnB, alB);
  __syncthreads(); RESC(alB);
  finishSM(pB0, pB1, alB, l_reg, pa0, pa1, pa2, pa3); SBAR();
  pv_d0(o, vb0 + (int)SHM_V, pa0, pa1, pa2, pa3);
  if (hi == 0) li_l[r32] = l_reg; asm volatile("s_waitcnt lgkmcnt(0)" ::: "memory");
  float rli[16];
#pragma unroll
  for (int r = 0; r < 16; ++r) rli[r] = __builtin_amdgcn_rcpf(li_l[crow(r, hi)]);
  bf16_t* Ow = Ob + (long)(wid * QBLK) * ldo;
#pragma unroll
  for (int r = 0; r < 16; ++r) { int orow = crow(r, hi);
    for (int d0 = 0; d0 < 4; ++d0) Ow[(long)orow * ldo + d0 * 32 + r32] = (bf16_t)(cvt_pk_bf16(o[d0][r] * rli[r], 0.f) & 0xffffu); }
  __syncthreads();
#undef SLOAD
#undef SWRITE
#undef SWAIT
#undef RESC
}
#undef KSWZ
#undef SBAR
}

struct Args { const float* in[22]; float* out; unsigned char* ws; };
enum { I_X = 0, I_C, I_CTX, I_CCTX, I_ADAW, I_ADAB, I_LNG, I_LNB, I_GQKV, I_GQN, I_GKN, I_GWO, I_DQKV, I_DLAM, I_DSUB, I_DWO, I_FW, I_FB, I_WUP, I_CW, I_CB, I_WDN };

struct Frame {
    LAS unsigned char* lds;
    int vcu, G;
};


typedef const float* cfptr_t;
typedef __attribute__((address_space(4))) const unsigned char* kseg_t;
__device__ __forceinline__ kseg_t kseg() { kseg_t ka = (kseg_t)__builtin_amdgcn_kernarg_segment_ptr(); asm volatile("" : "+s"(ka)); return ka; }
__device__ __forceinline__ const float* KIN(int k) { return *(const __attribute__((address_space(4))) cfptr_t*)(kseg() + 8 * k); }
__device__ __forceinline__ float* KOUT() { return *(float* const __attribute__((address_space(4)))*)(kseg() + 8 * 22); }
__device__ __forceinline__ unsigned char* KWS() { return *(unsigned char* const __attribute__((address_space(4)))*)(kseg() + 8 * 23); }
#define WSP(T, OFF) ((T*)(KWS() + (OFF)))

__device__ __forceinline__ void transpose_item(const float* W, int K, int N, bf16_t* WT, LAS float* scr, int item, int lane) {
    const int nblk = N / 64, kb = item / nblk, nb = item % nblk, k0 = 64 * kb, n0 = 64 * nb;
    const int lr = lane >> 4, lc = (lane & 15) * 4;
#pragma unroll
    for (int i = 0; i < 16; ++i) { const int kk = 4 * i + lr; const f32x4 v = *(const GAS f32x4*)(W + (size_t)(k0 + kk) * N + n0 + lc);
        LAS float* s = scr + kk * 65 + lc; s[0] = v[0]; s[1] = v[1]; s[2] = v[2]; s[3] = v[3]; }
    LDS_WAIT(); asm volatile("" ::: "memory");
    const int c = lane & 7;
#pragma unroll
    for (int j = 0; j < 8; ++j) { const int n = (lane >> 3) + 8 * j; const LAS float* s = scr + (8 * c) * 65 + n;
        u32x4 o; o.x = cvt_pk_bf16(s[0 * 65], s[1 * 65]); o.y = cvt_pk_bf16(s[2 * 65], s[3 * 65]); o.z = cvt_pk_bf16(s[4 * 65], s[5 * 65]); o.w = cvt_pk_bf16(s[6 * 65], s[7 * 65]);
        *(GAS u32x4*)(WT + (size_t)(n0 + n) * K + k0 + 8 * c) = o; }
    LDS_WAIT(); asm volatile("" ::: "memory");
}
__device__ __forceinline__ float silu_f(float x) { return x / (1.f + __expf(-x)); }

__global__ void __launch_bounds__(NWAVES * 64, 2) hybrid_fwd(Args args) {
    extern __shared__ __attribute__((aligned(16))) unsigned char lds[];
    Frame F;
    F.lds = (LAS unsigned char*)lds;
    F.G = gridDim.x; { const int bx = blockIdx.x; F.vcu = (F.G % 8 == 0) ? (bx % 8) * (F.G / 8) + bx / 8 : bx; }
    volatile LAS unsigned* MISC = (volatile LAS unsigned*)(F.lds + MISC_OFF);
    for (int u = threadIdx.x; u < (LDS_BYTES - LDSCTL_OFF) / 4; u += NWAVES * 64) ((LAS unsigned*)(F.lds + LDSCTL_OFF))[u] = 0u;
    __syncthreads();
    (void)xcd_barrier_post((unsigned*)(KWS() + WS_CTL) + CW_BAR, MISC + 8);
#define GRID_BAR() do { XcdBarrier b_; b_.bar = (unsigned*)(KWS() + WS_CTL) + CW_BAR; b_.x = xb_xcc_id(); b_.st = (volatile LAS unsigned*)(F.lds + MISC_OFF) + 8; xcd_barrier(b_); } while (0)
    const int NGW = F.G * NWAVES, NGT = F.G * NWAVES * 64;
#define PHASE_IDS const int tid_ = opq_tid(); const int lane_ = tid_ & 63; const int wave_ = __builtin_amdgcn_readfirstlane(tid_ >> 6); const int gw = F.vcu * NWAVES + wave_; const int gt = F.vcu * (NWAVES * 64) + tid_; (void)gw; (void)gt; (void)lane_;

#define MOD WSP(float, WS_MOD)
#define X WSP(float, WS_X)
#define OUTF WSP(float, WS_OUTF)
#define ABF WSP(bf16_t, WS_ABF)
#define QKV WSP(bf16_t, WS_QKV)
#define OATT WSP(bf16_t, WS_OATT)
#define OBF WSP(bf16_t, WS_OBF)
#define UB WSP(bf16_t, WS_U)
#define ACT WSP(bf16_t, WS_ACT)
#define ZT WSP(bf16_t, WS_ZT)
#define A2 WSP(bf16_t, WS_A2)
#define CS WSP(bf16_t, WS_CS)
#define ROPEC WSP(float, WS_ROPE)
#define ROPES (WSP(float, WS_ROPE) + SEQ * 64)

    {
        PHASE_IDS
        LAS float* scr = (LAS float*)(F.lds + wave_ * 16640);
        constexpr int I_QG = (DM / 64) * (3072 / 64), I_SQ = (DM / 64) * (DM / 64), I_QD = (DM / 64) * (6144 / 64), I_UP = (DM / 64) * (NUP / 64), I_DN = (DFF / 64) * (DM / 64);
        constexpr int NIT = 2 * I_QG + 2 * I_SQ + I_QD + I_SQ + I_SQ + 4 * I_UP + 4 * I_DN;
        for (int it = gw; it < NIT; it += NGW) {
            int r = it;
            if (r < 2 * I_QG) { const int j = r / I_QG; transpose_item(KIN(I_GQKV) + (size_t)j * DM * 3072, DM, 3072, (bf16_t*)(KWS() + WS_WQKV_G) + (size_t)j * 3072 * DM, scr, r % I_QG, lane_); continue; } r -= 2 * I_QG;
            if (r < 2 * I_SQ) { const int j = r / I_SQ; transpose_item(KIN(I_GWO) + (size_t)j * DM * DM, DM, DM, (bf16_t*)(KWS() + WS_WO_G) + (size_t)j * DM * DM, scr, r % I_SQ, lane_); continue; } r -= 2 * I_SQ;
            if (r < I_QD) { transpose_item(KIN(I_DQKV), DM, 6144, (bf16_t*)(KWS() + WS_WQKV_D), scr, r, lane_); continue; } r -= I_QD;
            if (r < I_SQ) { transpose_item(KIN(I_DWO), DM, DM, (bf16_t*)(KWS() + WS_WO_D), scr, r, lane_); continue; } r -= I_SQ;
            if (r < I_SQ) { transpose_item(KIN(I_FW), DM, DM, (bf16_t*)(KWS() + WS_WF), scr, r, lane_); continue; } r -= I_SQ;
            if (r < 4 * I_UP) { const int j = r / I_UP; transpose_item(KIN(I_WUP) + (size_t)j * DM * NUP, DM, NUP, (bf16_t*)(KWS() + WS_WUP) + (size_t)j * NUP * DM, scr, r % I_UP, lane_); continue; } r -= 4 * I_UP;
            { const int j = r / I_DN; transpose_item(KIN(I_WDN) + (size_t)j * DFF * DM, DFF, DM, (bf16_t*)(KWS() + WS_WDN) + (size_t)j * DM * DFF, scr, r % I_DN, lane_); }
        }
        {
            float* MODP = (float*)(KWS() + WS_MODP);
            for (int it = gw; it < DEPTH * 32 * 48; it += NGW) {
                const int nc = it % 48, kc = (it / 48) % 32, layer = it / (48 * 32);
                const float sl = silu_f(KIN(I_C)[kc * 64 + lane_]), sc = silu_f(KIN(I_CCTX)[kc * 64 + lane_]);
                const float* w = KIN(I_ADAW) + ((size_t)layer * DM + kc * 64) * NMOD + nc * 256 + lane_ * 4;
                f32x4 al = {0.f, 0.f, 0.f, 0.f}, ac = {0.f, 0.f, 0.f, 0.f};
#pragma unroll 16
                for (int k = 0; k < 64; ++k) { const f32x4 wv = *(const GAS f32x4*)(w + (size_t)k * NMOD);
                    const float a = __shfl(sl, k), b = __shfl(sc, k); al += wv * a; ac += wv * b; }
                float* o = MODP + ((size_t)(layer * 32 + kc) * 2) * NMOD + nc * 256 + lane_ * 4;
                *(GAS f32x4*)o = al; *(GAS f32x4*)(o + NMOD) = ac;
            }
        }
        for (int e = gt; e < SEQ * 64; e += NGT) { const int pos = e >> 6, a = e & 63, j = a & 31; const float p = (float)(a < 32 ? (pos >> 6) : (pos & 63));
            const float inv = powf(10000.f, -(float)j / 32.f); float s, c; sincosf(p * inv, &s, &c); ROPEC[e] = c; ROPES[e] = s; }
#if EN_FNET
        for (int e = gt; e < 1024 * 512; e += NGT) { const int c = e & 511, m = (e >> 9) & 511, trig = e >> 18; float s, co; sincospif((float)((m * c) & 511) * (1.f / 256.f), &s, &co);
            const float v = (trig ? s : co) * 0.044194173824159216f; CS[e] = (bf16_t)(cvt_pk_bf16(v, 0.f) & 0xffffu); }
        __syncthreads();
        { LAS float* ct = (LAS float*)F.lds;
          for (int j = tid_; j < 8192; j += NWAVES * 64) { float s, c; sincospif((float)j * (1.f / 4096.f), &s, &c); ct[j] = c; }
          __syncthreads();
          const float s8 = 0.011048543456039806f;
          for (long e8 = gt; e8 < (long)SEQ * (2 * SEQ / 8); e8 += NGT) { const int k = (int)(e8 >> 11), l0 = (int)(e8 & 2047) * 8; const int ph = l0 >= SEQ ? 2048 : 0, lb = l0 & (SEQ - 1);
              float v[8];
#pragma unroll
              for (int t = 0; t < 8; ++t) v[t] = ct[(k * (lb + t) + ph) & 8191] * s8;
              u32x4 o; o.x = cvt_pk_bf16(v[0], v[1]); o.y = cvt_pk_bf16(v[2], v[3]); o.z = cvt_pk_bf16(v[4], v[5]); o.w = cvt_pk_bf16(v[6], v[7]);
              *(GAS u32x4*)(A2 + (size_t)k * ZLD + l0) = o; }
          for (int e8 = gt; e8 < CTXL * (2 * CTXL / 8); e8 += NGT) { const int k = e8 >> 6, l0 = (e8 & 63) * 8; const int ph = l0 >= CTXL ? 2048 : 0, lb = l0 & (CTXL - 1);
              float v[8];
#pragma unroll
              for (int t = 0; t < 8; ++t) v[t] = ct[(32 * k * (lb + t) + ph) & 8191] * 0.0625f;
              u32x4 o; o.x = cvt_pk_bf16(v[0], v[1]); o.y = cvt_pk_bf16(v[2], v[3]); o.z = cvt_pk_bf16(v[4], v[5]); o.w = cvt_pk_bf16(v[6], v[7]);
              *(GAS u32x4*)(A2 + (size_t)(SEQ + k) * ZLD + 2 * SEQ + l0) = o; }
          __syncthreads(); }
#endif
    }
    GRID_BAR();
    {
        PHASE_IDS
        const float* MODP = (const float*)(KWS() + WS_MODP);
        for (int e = gt; e < DEPTH * 2 * NMOD; e += NGT) { const int n = e % NMOD, v = (e / NMOD) & 1, layer = e / (2 * NMOD);
            float s = KIN(I_ADAB)[layer * NMOD + n];
#pragma unroll 8
            for (int kc = 0; kc < 32; ++kc) s += MODP[((size_t)(layer * 32 + kc) * 2 + v) * NMOD + n];
            MOD[e] = s; }
    }
    GRID_BAR();
    { PHASE_IDS
    for (int row = gw; row < MROWS; row += NGW) {
        const int isc = row >= SEQ; const float* xin = isc ? KIN(I_CTX) + (size_t)(row - SEQ) * DM : KIN(I_X) + (size_t)row * DM;
        const float* mod = MOD + (size_t)isc * NMOD;
#pragma unroll
        for (int j = 0; j < 8; ++j) { const int c = 4 * lane_ + 256 * j; const f32x4 xv = *(const GAS f32x4*)(xin + c), sh = *(const GAS f32x4*)(mod + c), sc = *(const GAS f32x4*)(mod + DM + c);
            const f32x4 a = xv * (sc + 1.f) + sh; u32x2 w; w.x = cvt_pk_bf16(a[0], a[1]); w.y = cvt_pk_bf16(a[2], a[3]); *(GAS u32x2*)(ABF + (size_t)row * DM + c) = w; }
    } }
    GRID_BAR();

#pragma unroll 1
    for (int layer = 0; layer < DEPTH; ++layer) {
        const int kind = layer % 3, jidx = layer / 3;
        bool have_o = false;
        if ((kind == 0 && EN_GQA) || (kind == 1 && EN_DIFF) || (kind == 2 && EN_FNET)) {
            have_o = true;
            {
                pg8::Sched S; S.G = F.G; S.c = (int)blockIdx.x;
                pg8::EpiBf16 E;
                if (kind == 0) { S.A = (const char*)ABF; S.B = (const char*)(KWS() + WS_WQKV_G) + (size_t)jidx * 3072 * DM * 2; S.lda = DM; S.ldb = DM; S.nM = MROWS / 256; S.nN = 3072 / 256; S.nt = DM / 64; S.mode = 0; E.O = QKV; E.ldc = 3072; }
                else if (kind == 1) { S.A = (const char*)ABF; S.B = (const char*)(KWS() + WS_WQKV_D); S.lda = DM; S.ldb = DM; S.nM = MROWS / 256; S.nN = 6144 / 256; S.nt = DM / 64; S.mode = 0; E.O = QKV; E.ldc = 6144; }
                else { S.A = (const char*)CS; S.B = (const char*)ABF; S.lda = 512; S.ldb = DM; S.nM = 16; S.nN = MROWS / 256; S.nt = 8; S.mode = 1; E.O = ZT; E.ldc = ZLD; }
                pg8::gemm_phase<pg8::EpiBf16, true>(F.lds, S, E);
            }
            GRID_BAR();
            if (kind != 2) {
                PHASE_IDS
                const int ldq = kind == 0 ? 3072 : 6144, ngrp = kind == 0 ? 5 : 8;
                const int l16 = lane_ & 15, hq = lane_ >> 4;
                const int half = l16 >> 3, jb = 8 * (l16 & 3); const float sgn = (l16 & 4) ? 1.f : -1.f;
                for (int row = gw; row < MROWS; row += NGW) {
                    if (kind == 1 && row >= SEQ) continue;
                    for (int g = 0; g < ngrp; ++g) {
                        const int hv = g * 4 + hq;
                        bf16_t* p = QKV + (size_t)row * ldq + hv * 128 + l16 * 8;
                        const u32x4 raw = *(const GAS u32x4*)p;
                        float v[8] = {bf_lo(raw.x), bf_hi(raw.x), bf_lo(raw.y), bf_hi(raw.y), bf_lo(raw.z), bf_hi(raw.z), bf_lo(raw.w), bf_hi(raw.w)};
                        if (kind == 0) {
                            float ss = 0.f;
#pragma unroll
                            for (int t = 0; t < 8; ++t) ss += v[t] * v[t];
                            ss += __shfl_xor(ss, 1); ss += __shfl_xor(ss, 2); ss += __shfl_xor(ss, 4); ss += __shfl_xor(ss, 8);
                            const float inv = rsqrtf(ss * (1.f / 128.f) + LN_EPS);
                            const float* gn = (hv < 16 ? KIN(I_GQN) : KIN(I_GKN)) + jidx * 128 + l16 * 8;
                            const f32x4 g0 = *(const GAS f32x4*)gn, g1 = *(const GAS f32x4*)(gn + 4);
#pragma unroll
                            for (int t = 0; t < 4; ++t) { v[t] *= inv * g0[t]; v[4 + t] *= inv * g1[t]; }
                        }
                        if (row < SEQ) {
                            const float* cp = ROPEC + (size_t)row * 64 + half * 32 + jb; const float* sp = ROPES + (size_t)row * 64 + half * 32 + jb;
                            const f32x4 c0 = *(const GAS f32x4*)cp, c1 = *(const GAS f32x4*)(cp + 4), s0 = *(const GAS f32x4*)sp, s1 = *(const GAS f32x4*)(sp + 4);
#pragma unroll
                            for (int t = 0; t < 8; ++t) { const float pr = __shfl_xor(v[t], 4); const float c = t < 4 ? c0[t & 3] : c1[t & 3], s = t < 4 ? s0[t & 3] : s1[t & 3]; v[t] = v[t] * c + sgn * pr * s; }
                        }
                        u32x4 w; w.x = cvt_pk_bf16(v[0], v[1]); w.y = cvt_pk_bf16(v[2], v[3]); w.z = cvt_pk_bf16(v[4], v[5]); w.w = cvt_pk_bf16(v[6], v[7]);
                        *(GAS u32x4*)p = w;
                    }
                }
                GRID_BAR();
                {
                    const int nprob = kind == 0 ? 16 : 32, NU = nprob * (SEQ / 256);
                    const bool lastl = (layer == DEPTH - 1);
                    for (int i = 0;; ++i) {
                        const int L = i * F.G + F.vcu; int p, row0, seq, krow0;
                        if (L < NU) { p = L / (SEQ / 256); row0 = (L % (SEQ / 256)) * 256; seq = MROWS; krow0 = 0; }
                        else if (L < NU + nprob && !lastl) { p = L - NU; row0 = SEQ; seq = CTXL; krow0 = SEQ; }
                        else break;
                        const bf16_t *Qp, *Kp, *Vp; bf16_t* Op;
                        if (kind == 0) { Qp = QKV + (size_t)row0 * ldq + p * 128; Kp = QKV + (size_t)krow0 * ldq + 2048 + (p >> 2) * 128; Vp = Kp + 512; Op = OATT + (size_t)row0 * DM + p * 128; }
                        else { const int e = p & 1, c = (p >> 1) & 1, h = p >> 2, hh = 2 * h + c;
                            Qp = QKV + (size_t)row0 * ldq + hh * 128; Kp = QKV + (size_t)krow0 * ldq + 2048 + hh * 128; Vp = QKV + (size_t)krow0 * ldq + 4096 + h * 256 + e * 128;
                            Op = OATT + (size_t)c * MROWS * DM + (size_t)row0 * DM + h * 256 + e * 128; }
                        att::attn_unit(Qp, ldq, Kp, Vp, ldq, Op, DM, seq, (char*)lds);
                    }
                }
                GRID_BAR();
                if (kind == 1) {
                    PHASE_IDS
                    const float* lp = KIN(I_DLAM) + jidx * 512;
                    const float d1 = wave_sum(lp[lane_] * lp[128 + lane_] + lp[64 + lane_] * lp[192 + lane_]);
                    const float d2 = wave_sum(lp[256 + lane_] * lp[384 + lane_] + lp[320 + lane_] * lp[448 + lane_]);
                    const float lam_init = 0.8f - 0.6f * expf(-0.3f * (float)layer);
                    const float lam = expf(d1) - expf(d2) + lam_init, post = 1.f - lam_init;
                    const int l32 = lane_ & 31, h2 = lane_ >> 5;
                    const float* sg = KIN(I_DSUB) + jidx * 256 + l32 * 8; const f32x4 g0 = *(const GAS f32x4*)sg, g1 = *(const GAS f32x4*)(sg + 4);
                    for (int row = gw; row < MROWS; row += NGW)
                        for (int g = 0; g < 4; ++g) { const size_t off = (size_t)row * DM + (g * 2 + h2) * 256 + l32 * 8;
                            const u32x4 a = *(const GAS u32x4*)(OATT + off), b = *(const GAS u32x4*)(OATT + (size_t)MROWS * DM + off);
                            float v[8] = {bf_lo(a.x) - lam * bf_lo(b.x), bf_hi(a.x) - lam * bf_hi(b.x), bf_lo(a.y) - lam * bf_lo(b.y), bf_hi(a.y) - lam * bf_hi(b.y),
                                          bf_lo(a.z) - lam * bf_lo(b.z), bf_hi(a.z) - lam * bf_hi(b.z), bf_lo(a.w) - lam * bf_lo(b.w), bf_hi(a.w) - lam * bf_hi(b.w)};
                            float ss = 0.f;
#pragma unroll
                            for (int t = 0; t < 8; ++t) ss += v[t] * v[t];
                            ss += __shfl_xor(ss, 1); ss += __shfl_xor(ss, 2); ss += __shfl_xor(ss, 4); ss += __shfl_xor(ss, 8); ss += __shfl_xor(ss, 16);
                            const float inv = rsqrtf(ss * (1.f / 256.f) + LN_EPS) * post;
#pragma unroll
                            for (int t = 0; t < 4; ++t) { v[t] *= inv * g0[t]; v[4 + t] *= inv * g1[t]; }
                            u32x4 w; w.x = cvt_pk_bf16(v[0], v[1]); w.y = cvt_pk_bf16(v[2], v[3]); w.z = cvt_pk_bf16(v[4], v[5]); w.w = cvt_pk_bf16(v[6], v[7]);
                            *(GAS u32x4*)(OBF + off) = w; }
                    GRID_BAR();
                }
            } else {
                pg8::Sched S; S.G = F.G; S.c = (int)blockIdx.x; S.A = (const char*)A2; S.B = (const char*)ZT; S.lda = ZLD; S.ldb = ZLD; S.nM = 33; S.nN = 8; S.nt = 0; S.mode = 2;
                pg8::EpiBf16 E; E.O = OBF; E.ldc = DM;
                pg8::gemm_phase<pg8::EpiBf16, true>(F.lds, S, E);
                GRID_BAR();
            }
            {
                pg8::Sched S; S.G = F.G; S.c = (int)blockIdx.x; S.lda = DM; S.ldb = DM; S.nM = MROWS / 256; S.nN = DM / 256; S.nt = DM / 64; S.mode = 0;
                pg8::EpiF32 E; E.C = OUTF; E.ldc = DM; E.bias = nullptr;
                if (kind == 0) { S.A = (const char*)OATT; S.B = (const char*)(KWS() + WS_WO_G) + (size_t)jidx * DM * DM * 2; }
                else if (kind == 1) { S.A = (const char*)OBF; S.B = (const char*)(KWS() + WS_WO_D); }
                else { S.A = (const char*)OBF; S.B = (const char*)(KWS() + WS_WF); E.bias = KIN(I_FB) + jidx * DM; }
                pg8::gemm_phase<pg8::EpiF32, true>(F.lds, S, E);
            }
            GRID_BAR();
        }
#define LN_PHASE(WHICH, USE_O) do { PHASE_IDS \
        const float* lng = KIN(I_LNG) + (size_t)(layer * 2 + (WHICH)) * DM; const float* lnb = KIN(I_LNB) + (size_t)(layer * 2 + (WHICH)) * DM; \
        const bool fin = (layer == DEPTH - 1) && (WHICH) == 1; \
        for (int row = gw; row < MROWS; row += NGW) { \
            const int isc = row >= SEQ; if (fin && isc) continue; \
            const float* xin = (layer == 0 && (WHICH) == 0) ? (isc ? KIN(I_CTX) + (size_t)(row - SEQ) * DM : KIN(I_X) + (size_t)row * DM) : X + (size_t)row * DM; \
            const float* mod = MOD + (size_t)(layer * 2 + isc) * NMOD; const float* gate = mod + ((WHICH) ? 5 : 2) * DM; \
            const float* nsh = (WHICH) ? MOD + (size_t)(((layer + 1) & 3) * 2 + isc) * NMOD : mod + 3 * DM; const float* nsc = nsh + DM; \
            f32x4 v[8]; float s = 0.f; \
            _Pragma("unroll") for (int j = 0; j < 8; ++j) { const int c = 4 * lane_ + 256 * j; v[j] = *(const GAS f32x4*)(xin + c) * ALPHA_RES; \
                if (USE_O) v[j] += *(const GAS f32x4*)(gate + c) * *(const GAS f32x4*)(OUTF + (size_t)row * DM + c); \
                s += (v[j][0] + v[j][1]) + (v[j][2] + v[j][3]); } \
            const float mean = wave_sum(s) * (1.f / DM); float s2 = 0.f; \
            _Pragma("unroll") for (int j = 0; j < 8; ++j) { v[j] = v[j] - mean; s2 += (v[j][0] * v[j][0] + v[j][1] * v[j][1]) + (v[j][2] * v[j][2] + v[j][3] * v[j][3]); } \
            const float rstd = rsqrtf(wave_sum(s2) * (1.f / DM) + LN_EPS); \
            _Pragma("unroll") for (int j = 0; j < 8; ++j) { const int c = 4 * lane_ + 256 * j; \
                const f32x4 y = v[j] * rstd * *(const GAS f32x4*)(lng + c) + *(const GAS f32x4*)(lnb + c); \
                if (fin) { *(GAS f32x4*)(KOUT() + (size_t)row * DM + c) = y; } \
                else { *(GAS f32x4*)(X + (size_t)row * DM + c) = y; \
                    const f32x4 a = y * (*(const GAS f32x4*)(nsc + c) + 1.f) + *(const GAS f32x4*)(nsh + c); \
                    u32x2 w; w.x = cvt_pk_bf16(a[0], a[1]); w.y = cvt_pk_bf16(a[2], a[3]); *(GAS u32x2*)(ABF + (size_t)row * DM + c) = w; } } \
        } } while (0)
        if (have_o) LN_PHASE(0, true); else LN_PHASE(0, false);
        GRID_BAR();
#if EN_FFN
        {
            pg8::Sched S; S.G = F.G; S.c = (int)blockIdx.x; S.A = (const char*)ABF; S.B = (const char*)(KWS() + WS_WUP) + (size_t)layer * NUP * DM * 2; S.lda = DM; S.ldb = DM; S.nM = MROWS / 256; S.nN = NUP / 256; S.nt = DM / 64; S.mode = 0;
            pg8::EpiBf16 E; E.O = UB; E.ldc = NUP;
            pg8::gemm_phase<pg8::EpiBf16, true>(F.lds, S, E);
        }
        GRID_BAR();
        {
            PHASE_IDS
            const float* cw = KIN(I_CW) + (size_t)layer * 3 * NUP; const float* cb = KIN(I_CB) + (size_t)layer * NUP;
            for (int it = gt; it < (MROWS / 16) * (DFF / 8); it += NGT) {
                const int cg = it % (DFF / 8), rc = it / (DFF / 8), c0 = cg * 8, r0 = rc * 16;
                float wv[3][8], wg[3][8], bv[8], bg[8];
#pragma unroll
                for (int t = 0; t < 3; ++t)
#pragma unroll
                    for (int h = 0; h < 2; ++h) { const f32x4 a = *(const GAS f32x4*)(cw + (size_t)t * NUP + c0 + 4 * h), b = *(const GAS f32x4*)(cw + (size_t)t * NUP + DFF + c0 + 4 * h);
#pragma unroll
                        for (int q = 0; q < 4; ++q) { wv[t][4 * h + q] = a[q]; wg[t][4 * h + q] = b[q]; } }
#pragma unroll
                for (int h = 0; h < 2; ++h) { const f32x4 a = *(const GAS f32x4*)(cb + c0 + 4 * h), b = *(const GAS f32x4*)(cb + DFF + c0 + 4 * h);
#pragma unroll
                    for (int q = 0; q < 4; ++q) { bv[4 * h + q] = a[q]; bg[4 * h + q] = b[q]; } }
                const bool seg_first = (r0 == 0) || (r0 == SEQ), seg_last = (r0 + 16 == SEQ) || (r0 + 16 == MROWS);
                const bf16_t* up = UB + (size_t)r0 * NUP + c0;
                u32x4 pv = {0u, 0u, 0u, 0u}, pg = {0u, 0u, 0u, 0u};
                if (!seg_first) { pv = *(const GAS u32x4*)(up - NUP); pg = *(const GAS u32x4*)(up - NUP + DFF); }
                u32x4 cv = *(const GAS u32x4*)up, cg4 = *(const GAS u32x4*)(up + DFF);
                for (int r = 0; r < 16; ++r) {
                    u32x4 nv = {0u, 0u, 0u, 0u}, ng = {0u, 0u, 0u, 0u};
                    if (r < 15 || !seg_last) { nv = *(const GAS u32x4*)(up + (size_t)(r + 1) * NUP); ng = *(const GAS u32x4*)(up + (size_t)(r + 1) * NUP + DFF); }
                    float o[8];
#pragma unroll
                    for (int q = 0; q < 4; ++q) {
                        const unsigned a0 = pv[q], a1 = cv[q], a2 = nv[q], b0 = pg[q], b1 = cg4[q], b2 = ng[q];
                        const float v0 = wv[0][2 * q] * bf_lo(a0) + wv[1][2 * q] * bf_lo(a1) + wv[2][2 * q] * bf_lo(a2) + bv[2 * q];
                        const float v1 = wv[0][2 * q + 1] * bf_hi(a0) + wv[1][2 * q + 1] * bf_hi(a1) + wv[2][2 * q + 1] * bf_hi(a2) + bv[2 * q + 1];
                        const float g0 = wg[0][2 * q] * bf_lo(b0) + wg[1][2 * q] * bf_lo(b1) + wg[2][2 * q] * bf_lo(b2) + bg[2 * q];
                        const float g1 = wg[0][2 * q + 1] * bf_hi(b0) + wg[1][2 * q + 1] * bf_hi(b1) + wg[2][2 * q + 1] * bf_hi(b2) + bg[2 * q + 1];
                        o[2 * q] = silu_f(g0) * v0; o[2 * q + 1] = silu_f(g1) * v1;
                    }
                    u32x4 w; w.x = cvt_pk_bf16(o[0], o[1]); w.y = cvt_pk_bf16(o[2], o[3]); w.z = cvt_pk_bf16(o[4], o[5]); w.w = cvt_pk_bf16(o[6], o[7]);
                    *(GAS u32x4*)(ACT + (size_t)(r0 + r) * DFF + c0) = w;
                    pv = cv; pg = cg4; cv = nv; cg4 = ng;
                }
            }
        }
        GRID_BAR();
        {
            pg8::Sched S; S.G = F.G; S.c = (int)blockIdx.x; S.A = (const char*)ACT; S.B = (const char*)(KWS() + WS_WDN) + (size_t)layer * DM * DFF * 2; S.lda = DFF; S.ldb = DFF; S.nM = MROWS / 256; S.nN = DM / 256; S.nt = DFF / 64; S.mode = 0;
            pg8::EpiF32 E; E.C = OUTF; E.ldc = DM; E.bias = nullptr;
            pg8::gemm_phase<pg8::EpiF32, true>(F.lds, S, E);
        }
        GRID_BAR();
        LN_PHASE(1, true);
#else
        LN_PHASE(1, false);
#endif
        if (layer != DEPTH - 1) GRID_BAR();
    }
#undef LN_PHASE
#undef GRID_BAR
}

extern "C" void kernel_launch(void* const* d_in, const int* in_sizes, int n_in, void* d_out, int out_size, void* d_ws, size_t ws_size, hipStream_t stream) {
    static int grid = 0;
    if (grid == 0) {
        if (n_in != 22 || in_sizes[0] != SEQ * DM || out_size != SEQ * DM || ws_size < WS_END) {
            fprintf(stderr, "kernel_launch: unexpected shapes: n_in %d in0 %d out %d ws %zu (need >= %zu)\n", n_in, n_in > 0 ? in_sizes[0] : -1, out_size, ws_size, (size_t)WS_END); grid = -1; return; }
        int dev = 0, cus = 0, per_cu = 0;
        if (hipGetDevice(&dev) != hipSuccess || hipDeviceGetAttribute(&cus, hipDeviceAttributeMultiprocessorCount, dev) != hipSuccess) { grid = -1; return; }
        if (hipFuncSetAttribute((const void*)hybrid_fwd, hipFuncAttributeMaxDynamicSharedMemorySize, LDS_BYTES) != hipSuccess) { fprintf(stderr, "kernel_launch: hipFuncSetAttribute failed\n"); grid = -1; return; }
        if (hipOccupancyMaxActiveBlocksPerMultiprocessor(&per_cu, (const void*)hybrid_fwd, NWAVES * 64, LDS_BYTES) != hipSuccess || per_cu < 1)
            fprintf(stderr, "kernel_launch: note: occupancy query reports %d workgroups per CU\n", per_cu);
        (void)hipGetLastError();
        grid = cus;
        if (grid != 256) fprintf(stderr, "kernel_launch: note: %d CUs\n", grid);
    }
    if (grid < 0) return;
    if (hipMemsetAsync((char*)d_ws + WS_CTL, 0, CTL_ZERO_BYTES, stream) != hipSuccess) { fprintf(stderr, "kernel_launch: memset failed\n"); return; }
    Args a{};
    for (int i = 0; i < 22; ++i) a.in[i] = (const float*)d_in[i];
    a.out = (float*)d_out; a.ws = (unsigned char*)d_ws;
    hipLaunchKernelGGL(hybrid_fwd, dim3(grid), dim3(NWAVES * 64), LDS_BYTES, stream, a);
    const hipError_t le = hipPeekAtLastError();
    if (le != hipSuccess) fprintf(stderr, "kernel_launch: launch failed: %s\n", hipGetErrorName(le));
}
```

```cpp
#include <hip/hip_runtime.h>
#include <hip/hip_bf16.h>
#include <cstdio>
#include <cstdint>
#include <cmath>

#ifndef PROBE_TS
#define PROBE_TS 0
#endif
#ifndef TS_I1
#define TS_I1 0
#endif
#ifndef TS_I2
#define TS_I2 1
#endif
#ifndef EN_FFN
#define EN_FFN 1
#endif
#ifndef EN_GQA
#define EN_GQA 1
#endif
#ifndef EN_DIFF
#define EN_DIFF 1
#endif
#ifndef EN_FNET
#define EN_FNET 1
#endif

constexpr int DM = 2048, SEQ = 8192, CTXL = 256, MROWS = SEQ + CTXL, DEPTH = 4, DFF = 5632, NUP = 2 * DFF;
constexpr int NMOD = 6 * DM;
constexpr float ALPHA_RES = 1.6817928305074292f;
constexpr float LN_EPS = 1e-6f;
constexpr int ZLD = 2 * SEQ + 2 * CTXL;
constexpr int TLD = 2 * SEQ;

#define GAS __attribute__((address_space(1)))
#define LAS __attribute__((address_space(3)))
typedef unsigned short bf16_t;
typedef short bf16x8 __attribute__((ext_vector_type(8)));
typedef short s16x4 __attribute__((ext_vector_type(4)));
typedef float f32x4 __attribute__((ext_vector_type(4)));
typedef float f32x2 __attribute__((ext_vector_type(2)));
typedef float f32x16 __attribute__((ext_vector_type(16)));
typedef unsigned u32x4 __attribute__((ext_vector_type(4)));
typedef unsigned u32x2 __attribute__((ext_vector_type(2)));
typedef GAS unsigned gu32;

__device__ __forceinline__ unsigned cvt_pk_bf16(float lo, float hi) { unsigned r; asm volatile("v_cvt_pk_bf16_f32 %0, %1, %2" : "=v"(r) : "v"(lo), "v"(hi)); return r; }
__device__ __forceinline__ float bf_lo(unsigned u) { return __uint_as_float(u << 16); }
__device__ __forceinline__ float bf_hi(unsigned u) { return __uint_as_float(u & 0xffff0000u); }
__device__ __forceinline__ float wave_sum(float v) {
#pragma unroll
    for (int o = 1; o < 64; o <<= 1) v += __shfl_xor(v, o);
    return v;
}
__device__ __forceinline__ int opq_tid() { int t = threadIdx.x; asm volatile("" : "+v"(t)); return t; }
#define LDS_WAIT() asm volatile("s_waitcnt lgkmcnt(0)" ::: "memory")
#define VM_WAIT() asm volatile("s_waitcnt vmcnt(0)" ::: "memory")
#define RLX_AGENT __ATOMIC_RELAXED, __HIP_MEMORY_SCOPE_AGENT

constexpr size_t MiB = 1u << 20;
constexpr size_t WS_CTL = 0, CTL_ZERO_BYTES = 1 * MiB;
constexpr size_t WS_MODP = 1 * MiB;
constexpr size_t WS_MOD = 14 * MiB;
constexpr size_t WS_ROPE = 15 * MiB;
constexpr size_t WS_CS = 19 * MiB;
constexpr size_t WS_WQKV_G = 20 * MiB;
constexpr size_t WS_WO_G = 44 * MiB;
constexpr size_t WS_WQKV_D = 60 * MiB;
constexpr size_t WS_WO_D = 84 * MiB;
constexpr size_t WS_WF = 92 * MiB;
constexpr size_t WS_WUP = 100 * MiB;
constexpr size_t WS_WDN = 276 * MiB;
constexpr size_t WS_X = 364 * MiB;
constexpr size_t WS_OUTF = 430 * MiB;
constexpr size_t WS_ABF = 496 * MiB;
constexpr size_t WS_QKV = 529 * MiB;
constexpr size_t WS_OATT = 628 * MiB;
constexpr size_t WS_OBF = 694 * MiB;
constexpr size_t WS_U = 727 * MiB;
constexpr size_t WS_ACT = 909 * MiB;
constexpr size_t WS_ZT = 1000 * MiB;
constexpr size_t WS_T = 1066 * MiB;
constexpr size_t WS_WAT = 1130 * MiB;
constexpr size_t WS_WBT = 1132 * MiB;
constexpr size_t WS_A2C = 1140 * MiB;
constexpr size_t WS_PART = 1339 * MiB;
constexpr size_t WS_END = 1362 * MiB;
constexpr int CW_BAR = 4096;

constexpr int RING_BYTES = 131072;
constexpr int LDSCTL_OFF = 139264;
constexpr int MISC_OFF = LDSCTL_OFF + 320;
constexpr int LDS_BYTES = 147456;
constexpr int NWAVES = 8;
constexpr int NSPLIT_WO = 4, NSPLIT_DN = 11;

#define XB_TMO      128
#define XB_XCNT(j)  (256  + 64 * (j))
#define XB_XSUB(j)  (1280 + 64 * (j))
#define XB_XGEN(j)  (2304 + 64 * (j))
#define XB_TOP      3328
#define XB_TOPGEN   3392
#define XCD_BAR_WORDS 3456
#define XB_SPIN_CAP (1u << 22)

__device__ __forceinline__ unsigned xb_ld(unsigned* p)              { return __hip_atomic_load(p, __ATOMIC_RELAXED, __HIP_MEMORY_SCOPE_AGENT); }
__device__ __forceinline__ unsigned xb_add(unsigned* p, unsigned v) { return __hip_atomic_fetch_add(p, v, __ATOMIC_RELAXED, __HIP_MEMORY_SCOPE_AGENT); }
__device__ __forceinline__ unsigned xb_xcc_id() { return (unsigned)__builtin_amdgcn_s_getreg((3 << 11) | 20) & 0xFu; }
#define XB_SPIN(cond, bar) do { unsigned _sp = 0; while (cond) { __builtin_amdgcn_s_sleep(1); \
    if ((++_sp & 255u) == 0u) { if (xb_ld(&(bar)[XB_TMO])) break; if (_sp > XB_SPIN_CAP) { atomicAdd(&(bar)[XB_TMO], 1u); break; } } } } while (0)

struct XcdBarrier { unsigned* bar; unsigned x; volatile LAS unsigned* st; };

__device__ __forceinline__ XcdBarrier xcd_barrier_post(unsigned* bar, volatile LAS unsigned* st) {
    XcdBarrier b; b.bar = bar; b.x = xb_xcc_id(); b.st = st;
    if (threadIdx.x == 0) (void)xb_add(&bar[XB_XCNT(b.x)], 1u);
    return b;
}
__device__ __forceinline__ void xcd_barrier_complete(unsigned* bar, unsigned x, unsigned& nloc, unsigned& nx) {
    const unsigned G = gridDim.x * gridDim.y * gridDim.z;
    unsigned sum, cnt, mine, sp = 0u;
    for (;;) {
        sum = 0u; cnt = 0u; mine = 0u;
#pragma unroll
        for (unsigned j = 0; j < 16; ++j) { const unsigned c = xb_ld(&bar[XB_XCNT(j)]); sum += c; cnt += (c > 0u) ? 1u : 0u; mine = (j == x) ? c : mine; }
        if (sum == G) break;
        __builtin_amdgcn_s_sleep(1);
        if ((++sp & 255u) == 0u) { if (xb_ld(&bar[XB_TMO])) break; if (sp > XB_SPIN_CAP) { atomicAdd(&bar[XB_TMO], 1u); break; } }
    }
    nloc = mine > 0u ? mine : 1u; nx = cnt > 0u ? cnt : 1u;
}
__device__ __forceinline__ void xcd_barrier(const XcdBarrier& b) {
    asm volatile("s_waitcnt vmcnt(0)" ::: "memory");
    __syncthreads();
    if (threadIdx.x == 0) {
        unsigned* bar = b.bar;
        __builtin_amdgcn_s_waitcnt(0);
        unsigned nloc = b.st[0], nx = b.st[1];
        if (nloc == 0u) { xcd_barrier_complete(bar, b.x, nloc, nx); b.st[0] = nloc; b.st[1] = nx; }
        const unsigned old = xb_add(&bar[XB_XSUB(b.x)], 1u);
        const unsigned gen = old / nloc;
        if (old + 1u == (gen + 1u) * nloc) {
            __builtin_amdgcn_fence(__ATOMIC_RELEASE, "agent");
            asm volatile("s_waitcnt vmcnt(0)" ::: "memory");
            const unsigned og = xb_add(&bar[XB_TOP], 1u);
            const unsigned tg = og / nx;
            if (og + 1u == (tg + 1u) * nx) xb_add(&bar[XB_TOPGEN], 1u);
            else XB_SPIN(xb_ld(&bar[XB_TOPGEN]) == tg, bar);
            __builtin_amdgcn_fence(__ATOMIC_ACQUIRE, "agent");
            xb_add(&bar[XB_XGEN(b.x)], 1u);
            asm volatile("s_waitcnt vmcnt(0)" ::: "memory");
        } else {
            XB_SPIN(xb_ld(&bar[XB_XGEN(b.x)]) == gen, bar);
            __builtin_amdgcn_fence(__ATOMIC_ACQUIRE, "agent");
            asm volatile("s_waitcnt vmcnt(0)" ::: "memory");
        }
    }
    __syncthreads();
}

namespace pg8 {
constexpr int BM = 256, BK = 64, HALF = 128, HTB = HALF * BK * 2, STAGE_BYTES = 8 * HTB, NXCD = 8, WGM = 8;
__host__ __device__ __forceinline__ int lds_byte(int r, int c) { const int st = (r >> 4) * 2 + (c >> 5), rr = r & 15, cc = c & 31, ob = rr * 64 + cc * 2; return st * 1024 + (ob ^ (((ob >> 9) & 1) << 5)); }
__host__ __device__ __forceinline__ void stage_rc(int b, int& R, int& C) { const int st = b / 1024, sb = b % 1024, swz = sb ^ (((sb >> 9) & 1) << 5); R = (st >> 1) * 16 + swz / 64; C = (st & 1) * 32 + (swz % 64) / 2; }
__host__ __device__ __forceinline__ int perm32(int rho) { const int n = rho >> 4, i = rho & 15; return 8 * (i >> 2) + 4 * n + (i & 3); }

struct Unit { const char* A; const char* B; int nt, orow, ocol, osel; };

struct Sched {
    const char* A; const char* B; int lda, ldb, nM, nN, nt, mode, G, c, ks, nsplit, bmap;
    __device__ __forceinline__ bool next(int i, Unit& u) const {
        u.osel = 0;
        if (mode == 3) {
            const long L = (long)i * G + c; if (L >= 256 + 8 * nsplit) return false;
            if (L < 256) { const int vc = ((int)L % 8) * 32 + (int)L / 8, pm = vc >> 3, pn = vc & 7;
                u.A = A + (size_t)pm * 256 * lda * 2; u.B = B + (size_t)pn * 256 * ldb * 2; u.nt = nt; u.orow = pm * 256; u.ocol = pn * 256; }
            else { const int idx = (int)L - 256, pn = idx & 7, sp = idx >> 3;
                u.A = A + ((size_t)SEQ * lda + (size_t)sp * ks * 64) * 2; u.B = B + ((size_t)pn * 256 * ldb + (size_t)sp * ks * 64) * 2; u.nt = ks; u.orow = sp * 256; u.ocol = pn * 256; u.osel = 1; }
            return true;
        }
        const int nwg = nM * nN; const long L = (long)i * G + c; if (L >= nwg) return false;
        if (mode == 6) {
            if (L >= 16) return false; const int pm = (int)L, g = pm >> 2, trig = (pm >> 1) & 1, mb = pm & 1;
            u.A = A + (size_t)((trig * 2 + mb) * 256) * 512 * 2; u.B = B + ((size_t)SEQ * DM + 512 * g) * 2; u.nt = 8; u.orow = g * 512 + mb * 256; u.ocol = 2 * SEQ + trig * CTXL; return true; }
        if (mode == 7) {
            if (L >= 8) return false; const int pn = (int)L;
            u.A = A; u.B = B + ((size_t)pn * 256 * ZLD + 2 * SEQ) * 2; u.nt = 8; u.orow = SEQ; u.ocol = pn * 256; return true; }
        int wgid = (int)L; { const int q = nwg / NXCD, r = nwg % NXCD, xcd = wgid % NXCD, off = wgid / NXCD; wgid = (xcd < r ? xcd * (q + 1) : r * (q + 1) + (xcd - r) * q) + off; }
        const int nig = WGM * nN, gid = wgid / nig, fm = gid * WGM, gsz = (nM - fm) < WGM ? (nM - fm) : WGM;
        const int pm = fm + ((wgid % nig) % gsz), pn = (wgid % nig) / gsz;
        if (mode == 0) { u.A = A + (size_t)pm * 256 * lda * 2; u.B = B + (size_t)pn * 256 * ldb * 2; u.nt = nt; u.orow = pm * 256; u.ocol = pn * 256; }
        else if (mode == 1) {
            const int g = pm >> 2, trig = (pm >> 1) & 1, mb = pm & 1;
            u.A = A + (size_t)((trig * 2 + mb) * 256) * 512 * 2; u.B = B + ((size_t)(4 * pn) * DM + 512 * g) * 2; u.nt = 8;
            u.orow = g * 512 + mb * 256; u.ocol = 4 * pn * 128 + trig * 64;
        } else if (mode == 4) {
            const int l2b = pn >> 2, kb = pn & 3;
            u.A = A + ((size_t)pm * 256 * ZLD + (size_t)l2b * 1024) * 2; u.B = B + (size_t)kb * 256 * 1024 * 2; u.nt = 16; u.orow = pm * 256; u.ocol = kb * 16 * 256 + l2b * 8;
        } else {
            u.A = A + (size_t)pm * 256 * 512 * 2; u.B = B + ((size_t)pn * 256 * TLD + (size_t)pm * 512) * 2; u.nt = 8; u.orow = 2 * pm; u.ocol = pn * 256;
        }
        return true;
    }
};

struct EpiBf16 {
    static constexpr bool PERM = true;
    bf16_t* O; int ldc, cmode, rmode;
    __device__ __forceinline__ void operator()(const f32x4 (&acc)[2][2][4][2], const Unit& u, int wr, int wc, int fr, int fq) const {
#pragma unroll
        for (int ai = 0; ai < 2; ++ai)
#pragma unroll
            for (int m = 0; m < 4; ++m) { const int r = ai * HALF + wr * 64 + m * 16 + fr; const int row = u.orow + (rmode ? (r >> 7) + 64 * (r & 127) : r);
                bf16_t* rowp = O + (size_t)row * ldc + u.ocol;
#pragma unroll
                for (int bj = 0; bj < 2; ++bj) { const f32x4 v0 = acc[ai][bj][m][0], v1 = acc[ai][bj][m][1];
                    const int j = bj * HALF + wc * 32 + 8 * fq; const int co = cmode == 0 ? j : (cmode == 1 ? (j >> 6) * 128 + (j & 63) : (j >> 4) * 256 + ((j >> 3) & 1) * 128);
                    u32x4 w; w.x = cvt_pk_bf16(v0[0], v0[1]); w.y = cvt_pk_bf16(v0[2], v0[3]); w.z = cvt_pk_bf16(v1[0], v1[1]); w.w = cvt_pk_bf16(v1[2], v1[3]);
                    *(u32x4*)(rowp + co) = w; } }
    }
};
struct EpiF32 {
    static constexpr bool PERM = false;
    float* C; int ldc; const float* bias; float* Cpart;
    __device__ __forceinline__ void operator()(const f32x4 (&acc)[2][2][4][2], const Unit& u, int wr, int wc, int fr, int fq) const {
        const int col0 = u.ocol + wc * 32 + 4 * fq; float* const Cb = u.osel ? Cpart : C; const bool addb = (bias != nullptr) && (u.osel == 0 || u.orow == 0);
        f32x4 bv[2][2];
#pragma unroll
        for (int bj = 0; bj < 2; ++bj)
#pragma unroll
            for (int n = 0; n < 2; ++n) bv[bj][n] = addb ? *(const f32x4*)(bias + col0 + bj * HALF + n * 16) : (f32x4){0.f, 0.f, 0.f, 0.f};
#pragma unroll
        for (int ai = 0; ai < 2; ++ai)
#pragma unroll
            for (int m = 0; m < 4; ++m) { float* rowp = Cb + (size_t)(u.orow + wr * 64 + fr + ai * HALF + m * 16) * ldc + col0;
#pragma unroll
                for (int bj = 0; bj < 2; ++bj)
#pragma unroll
                    for (int n = 0; n < 2; ++n) *(f32x4*)(rowp + bj * HALF + n * 16) = acc[ai][bj][m][n] + bv[bj][n]; }
    }
};

template <class Epi, bool ALIGN_EPI>
__device__ __forceinline__ void gemm_phase(LAS unsigned char* lds, const Sched& S, const Epi& E) {
    const int tid = opq_tid(), wid = __builtin_amdgcn_readfirstlane(tid >> 6), lane = tid & 63, wr = wid >> 2, wc = wid & 3, fr = lane & 15, fq = lane >> 4;
    const int lda = S.lda, ldb = S.ldb;
    unsigned voffA[2], voffB[2];
#pragma unroll
    for (int i = 0; i < 2; ++i) { int R, C; stage_rc(tid * 16 + i * 8192, R, C); const int Rb = Epi::PERM ? ((R & ~31) + perm32(R & 31)) : R;
        voffA[i] = (unsigned)(R * lda + C) * 2u; voffB[i] = (unsigned)((S.bmap ? 128 * (Rb & 63) + (Rb >> 6) : Rb) * ldb + C) * 2u; }
    const size_t kstep = (size_t)(BK * 2);
    const size_t hstepA = (size_t)HALF * lda * 2, hstepB = (size_t)(S.bmap ? 2 : HALF) * ldb * 2;
    const unsigned ldsw = (unsigned)wid * 1024u;
    const int aoff = lds_byte(wr * 64 + fr, fq * 8), boff = lds_byte(wc * 32 + fr, fq * 8);
#define PG8_SA(b, h) (((b) * 2 + (h)) * HTB)
#define PG8_SB(b, h) ((4 + (b) * 2 + (h)) * HTB)
#define PG8_STAGE(bufoff, gbase, voff) do { _Pragma("unroll") for (int _i = 0; _i < 2; ++_i) \
        __builtin_amdgcn_global_load_lds((const unsigned*)((const char*)(gbase) + (voff)[_i]), (LAS unsigned*)(lds + (bufoff) + ldsw + _i * 8192), 16, 0, 0); } while (0)
#define PG8_LDA(dst, b, h) do { _Pragma("unroll") for (int m = 0; m < 4; ++m) _Pragma("unroll") for (int k = 0; k < 2; ++k) dst[m][k] = *(const LAS bf16x8*)(lds + PG8_SA(b, h) + aoff + m * 2048 + k * 1024); } while (0)
#define PG8_LDB(dst, b, h) do { _Pragma("unroll") for (int n = 0; n < 2; ++n) _Pragma("unroll") for (int k = 0; k < 2; ++k) dst[n][k] = *(const LAS bf16x8*)(lds + PG8_SB(b, h) + boff + n * 2048 + k * 1024); } while (0)
#define PG8_MMA(ai, bj, At, Bt) do { __builtin_amdgcn_s_setprio(1); _Pragma("unroll") for (int m = 0; m < 4; ++m) _Pragma("unroll") for (int n = 0; n < 2; ++n) _Pragma("unroll") for (int k = 0; k < 2; ++k) \
        acc[ai][bj][m][n] = __builtin_amdgcn_mfma_f32_16x16x32_bf16(Bt[n][k], At[m][k], acc[ai][bj][m][n], 0, 0, 0); __builtin_amdgcn_s_setprio(0); } while (0)
#define PG8_WAIT_V(n) asm volatile("s_waitcnt vmcnt(" #n ")" ::: "memory")
#define PG8_WAIT_L(n) asm volatile("s_waitcnt lgkmcnt(" #n ")" ::: "memory")
#define PG8_BAR __builtin_amdgcn_s_barrier()
#define PG8_SCHED __builtin_amdgcn_sched_barrier(0)
    Unit cur, nxt; int ui = 0;
    if (!S.next(0, cur)) return;
    f32x4 acc[2][2][4][2];
#pragma unroll
    for (int a = 0; a < 2; ++a)
#pragma unroll
        for (int b = 0; b < 2; ++b)
#pragma unroll
            for (int m = 0; m < 4; ++m)
#pragma unroll
                for (int n = 0; n < 2; ++n) acc[a][b][m][n] = (f32x4){0.f, 0.f, 0.f, 0.f};
    bf16x8 At[4][2], B0[2][2], B1[2][2];
    const char* cA = cur.A; const char* cB = cur.B;
    PG8_STAGE(PG8_SB(0, 0), cB, voffB); PG8_STAGE(PG8_SB(0, 1), cB + hstepB, voffB); PG8_STAGE(PG8_SA(0, 0), cA, voffA); PG8_STAGE(PG8_SA(0, 1), cA + hstepA, voffA);
    if (wr == 1) PG8_BAR;
    PG8_WAIT_V(2); PG8_BAR;
    PG8_STAGE(PG8_SB(1, 0), cB + kstep, voffB); PG8_STAGE(PG8_SA(1, 0), cA + kstep, voffA); PG8_STAGE(PG8_SB(1, 1), cB + hstepB + kstep, voffB);
    PG8_WAIT_V(6); PG8_BAR;
    for (;;) {
        const bool has_next = S.next(ui + 1, nxt);
        const char* nA = has_next ? nxt.A : cA; const char* nB = has_next ? nxt.B : cB;
        const int nt = cur.nt;
        for (int t = 0; t < nt; t += 2) {
            const bool last = (t == nt - 2);
            const char* a1 = cA + (size_t)(t + 1) * kstep;
            const char* a2 = last ? nA : cA + (size_t)(t + 2) * kstep; const char* b2 = last ? nB : cB + (size_t)(t + 2) * kstep;
            const char* a3 = a2 + kstep; const char* b3 = b2 + kstep;
            PG8_LDB(B0, 0, 0); PG8_LDB(B1, 0, 1); PG8_SCHED; PG8_LDA(At, 0, 0); PG8_STAGE(PG8_SA(1, 1), a1 + hstepA, voffA);
            PG8_WAIT_V(8); PG8_WAIT_L(0); PG8_BAR; PG8_MMA(0, 0, At, B0); PG8_MMA(0, 1, At, B1); PG8_BAR; PG8_SCHED;
            PG8_LDA(At, 0, 1); PG8_STAGE(PG8_SB(0, 0), b2, voffB); PG8_STAGE(PG8_SB(0, 1), b2 + hstepB, voffB); PG8_STAGE(PG8_SA(0, 0), a2, voffA);
            PG8_WAIT_V(8); PG8_WAIT_L(0); PG8_BAR; PG8_MMA(1, 0, At, B0); PG8_MMA(1, 1, At, B1); PG8_BAR; PG8_SCHED;
            PG8_LDB(B0, 1, 0); PG8_LDB(B1, 1, 1); PG8_SCHED; PG8_LDA(At, 1, 0); PG8_STAGE(PG8_SA(0, 1), a2 + hstepA, voffA);
            PG8_WAIT_V(8); PG8_WAIT_L(0); PG8_BAR; PG8_MMA(0, 0, At, B0); PG8_MMA(0, 1, At, B1); PG8_BAR; PG8_SCHED;
            PG8_LDA(At, 1, 1); PG8_STAGE(PG8_SB(1, 0), b3, voffB); PG8_STAGE(PG8_SB(1, 1), b3 + hstepB, voffB); PG8_STAGE(PG8_SA(1, 0), a3, voffA);
            PG8_WAIT_V(8); PG8_WAIT_L(0); PG8_BAR; PG8_MMA(1, 0, At, B0); PG8_MMA(1, 1, At, B1); PG8_BAR; PG8_SCHED;
        }
        if constexpr (ALIGN_EPI) { if (wr == 0) PG8_BAR; }
        E(acc, cur, wr, wc, fr, fq);
        if (!has_next) break;
#pragma unroll
        for (int a = 0; a < 2; ++a)
#pragma unroll
            for (int b = 0; b < 2; ++b)
#pragma unroll
                for (int m = 0; m < 4; ++m)
#pragma unroll
                    for (int n = 0; n < 2; ++n) acc[a][b][m][n] = (f32x4){0.f, 0.f, 0.f, 0.f};
        cur = nxt; cA = nA; cB = nB; ++ui;
        if constexpr (ALIGN_EPI) { if (wr == 1) PG8_BAR; }
    }
    PG8_WAIT_V(0);
    if constexpr (!ALIGN_EPI) { if (wr == 0) PG8_BAR; }
    PG8_BAR;
#undef PG8_SA
#undef PG8_SB
#undef PG8_STAGE
#undef PG8_LDA
#undef PG8_LDB
#undef PG8_MMA
#undef PG8_WAIT_V
#undef PG8_WAIT_L
#undef PG8_BAR
#undef PG8_SCHED
}
}

namespace att {
constexpr int D = 128, NW = 8, QBLK = 32, KVBLK = 64;
constexpr float SCALE = 0.088388347648318440f;
constexpr float THR = 8.f;
constexpr size_t SHM_V = KVBLK * D * 2, SHM_K = KVBLK * D * 2, SHM_ATTN = 2 * SHM_V + 2 * SHM_K + NW * 64 * 4;
#define KSWZ(row, colB) ((row) * 256 + ((colB) ^ (((row) & 7) << 4)))
#define SBAR() __builtin_amdgcn_sched_barrier(0)
__device__ __forceinline__ int crow(int r, int hi) { return (r & 3) + 8 * (r >> 2) + 4 * hi; }
__device__ __forceinline__ void partialSM(f32x16& p0, f32x16& p1, float& m_reg, float& mn, float& alpha) {
  constexpr float C = SCALE * 1.4426950408889634f;
  float pmax = p0[0]; for (int r = 1; r < 16; ++r) pmax = fmaxf(pmax, p0[r]); for (int r = 0; r < 16; ++r) pmax = fmaxf(pmax, p1[r]);
  { auto rr = __builtin_amdgcn_permlane32_swap(__float_as_uint(pmax), __float_as_uint(pmax), false, false);
    pmax = fmaxf(__uint_as_float(rr[0]), __uint_as_float(rr[1])); }
  if (__builtin_expect(__all(pmax - m_reg <= THR / SCALE), 1)) { mn = m_reg; alpha = 1.f; }
  else { mn = fmaxf(m_reg, pmax); alpha = __builtin_amdgcn_exp2f((m_reg - mn) * C); m_reg = mn; }
  float mnC = -mn * C;
  for (int r = 0; r < 16; ++r) p0[r] = fmaf(p0[r], C, mnC); for (int r = 0; r < 16; ++r) p1[r] = fmaf(p1[r], C, mnC);
  for (int r = 0; r < 16; ++r) p0[r] = __builtin_amdgcn_exp2f(p0[r]);
}
__device__ __forceinline__ void finishSM(f32x16& p0, f32x16& p1, float alpha, float& l_reg, bf16x8& pa0, bf16x8& pa1, bf16x8& pa2, bf16x8& pa3) {
  for (int r = 0; r < 16; ++r) p1[r] = __builtin_amdgcn_exp2f(p1[r]);
  float ps = 0; for (int r = 0; r < 16; ++r) ps += p0[r]; for (int r = 0; r < 16; ++r) ps += p1[r];
  { auto rr = __builtin_amdgcn_permlane32_swap(__float_as_uint(ps), __float_as_uint(ps), false, false);
    ps = __uint_as_float(rr[0]) + __uint_as_float(rr[1]); }
  l_reg = l_reg * alpha + ps;
#define PK4(P, BASE, OUT) do { unsigned a0 = cvt_pk_bf16(P[BASE + 0], P[BASE + 1]), a1 = cvt_pk_bf16(P[BASE + 2], P[BASE + 3]);   \
    unsigned b0 = cvt_pk_bf16(P[BASE + 4], P[BASE + 5]), b1 = cvt_pk_bf16(P[BASE + 6], P[BASE + 7]);                              \
    auto r0 = __builtin_amdgcn_permlane32_swap(a0, b0, false, false); auto r1 = __builtin_amdgcn_permlane32_swap(a1, b1, false, false); \
    u32x4 w = {r0[0], r1[0], r0[1], r1[1]}; OUT = *reinterpret_cast<bf16x8*>(&w); } while (0)
  PK4(p0, 0, pa0); PK4(p0, 8, pa1); PK4(p1, 0, pa2); PK4(p1, 8, pa3);
#undef PK4
}
__device__ __forceinline__ void qkt(f32x16& p0, f32x16& p1, const bf16_t* Ks, const bf16x8* qr, int r32, int hi) {
  p0 = f32x16{}; p1 = f32x16{};
  for (int d0 = 0; d0 < 8; ++d0) { int cb = (d0 * 16 + hi * 8) * 2;
    bf16x8 b0 = *reinterpret_cast<const bf16x8*>((const char*)Ks + KSWZ(r32, cb));
    bf16x8 b1 = *reinterpret_cast<const bf16x8*>((const char*)Ks + KSWZ(32 + r32, cb));
    p0 = __builtin_amdgcn_mfma_f32_32x32x16_bf16(b0, qr[d0], p0, 0, 0, 0);
    p1 = __builtin_amdgcn_mfma_f32_32x32x16_bf16(b1, qr[d0], p1, 0, 0, 0); }
}
__device__ __forceinline__ int v_st(int k, int c) { const int kk = (k & ~0xC) | ((k & 4) << 1) | ((k & 8) >> 1); return ((kk >> 3) * 4 + (c >> 5)) * 512 + ((kk & 7) * 32 + (c & 31)) * 2; }
__device__ __forceinline__ int v_rd_base(int lane) { return ((lane & 3) << 3) | (((lane >> 2) & 3) << 6) | (((lane >> 4) & 1) << 5) | (((lane >> 5) & 1) << 8); }
constexpr int v_rd_off(int d0, int ks, int half) { return d0 * 512 + ks * 4096 + half * 2048; }
template <int OFF> __device__ __forceinline__ s16x4 tr_read(int vb) {
  s16x4 r; asm volatile("ds_read_b64_tr_b16 %0, %1 offset:%2" : "=&v"(r) : "v"(vb), "i"(OFF) : "memory"); return r;
}
template <int D0> __device__ __forceinline__ void pv_one(f32x16& od, int vb, bf16x8 pa0, bf16x8 pa1, bf16x8 pa2, bf16x8 pa3) {
  const s16x4 l0 = tr_read<v_rd_off(D0, 0, 0)>(vb), h0 = tr_read<v_rd_off(D0, 0, 1)>(vb), l1 = tr_read<v_rd_off(D0, 1, 0)>(vb), h1 = tr_read<v_rd_off(D0, 1, 1)>(vb);
  const s16x4 l2 = tr_read<v_rd_off(D0, 2, 0)>(vb), h2 = tr_read<v_rd_off(D0, 2, 1)>(vb), l3 = tr_read<v_rd_off(D0, 3, 0)>(vb), h3 = tr_read<v_rd_off(D0, 3, 1)>(vb);
  asm volatile("s_waitcnt lgkmcnt(0)" ::: "memory"); SBAR();
#define PK(L, H) (bf16x8){L[0], L[1], L[2], L[3], H[0], H[1], H[2], H[3]}
  od = __builtin_amdgcn_mfma_f32_32x32x16_bf16(pa0, PK(l0, h0), od, 0, 0, 0);
  od = __builtin_amdgcn_mfma_f32_32x32x16_bf16(pa1, PK(l1, h1), od, 0, 0, 0);
  od = __builtin_amdgcn_mfma_f32_32x32x16_bf16(pa2, PK(l2, h2), od, 0, 0, 0);
  od = __builtin_amdgcn_mfma_f32_32x32x16_bf16(pa3, PK(l3, h3), od, 0, 0, 0);
#undef PK
}
__device__ __forceinline__ void pv_d0(f32x16* o, int vb, bf16x8 pa0, bf16x8 pa1, bf16x8 pa2, bf16x8 pa3) {
  pv_one<0>(o[0], vb, pa0, pa1, pa2, pa3); pv_one<1>(o[1], vb, pa0, pa1, pa2, pa3); pv_one<2>(o[2], vb, pa0, pa1, pa2, pa3); pv_one<3>(o[3], vb, pa0, pa1, pa2, pa3);
}
__device__ __forceinline__ void attn_unit(const bf16_t* __restrict__ Qb, int ldq, const bf16_t* __restrict__ Kh, const bf16_t* __restrict__ Vh, int ldk,
                                          bf16_t* __restrict__ Ob, int ldo, int seq, char* lds) {
  const int tid = opq_tid(), wid = tid >> 6, lane = tid & 63, r32 = lane & 31, hi = lane >> 5;
  bf16_t* V_lds = (bf16_t*)lds; bf16_t* K_lds = (bf16_t*)(lds + 2 * SHM_V);
  float* ws = (float*)(lds + 2 * SHM_V + 2 * SHM_K) + wid * 64; float* li_l = ws; float* al_l = ws + 32;
  float m_reg = -1e30f, l_reg = 0; f32x16 o[4] = {}; bf16x8 qr[8];
  const bf16_t* Qw = Qb + (long)(wid * QBLK + r32) * ldq + hi * 8;
#pragma unroll
  for (int d0 = 0; d0 < 8; ++d0) qr[d0] = *reinterpret_cast<const bf16x8*>(Qw + d0 * 16);
  const int sr = tid >> 4, sc = (tid & 15) * 8, vst0 = v_st(sr, sc), vst1 = v_st(32 + sr, sc);
  const int vb0 = (int)(uintptr_t)V_lds + v_rd_base(lane);
  struct { bf16x8 vs0, vs1, ks0, ks1; } sr_[2];
  const bf16_t* Vp = Vh + (long)sr * ldk + sc; const bf16_t* Kp = Kh + (long)sr * ldk + sc; const long r32s = 32L * ldk;
#define SLOAD(i, k0) do { const long ko_ = (long)(k0) * ldk; sr_[i].vs0 = *reinterpret_cast<const bf16x8*>(Vp + ko_); sr_[i].vs1 = *reinterpret_cast<const bf16x8*>(Vp + ko_ + r32s); \
    sr_[i].ks0 = *reinterpret_cast<const bf16x8*>(Kp + ko_); sr_[i].ks1 = *reinterpret_cast<const bf16x8*>(Kp + ko_ + r32s); } while (0)
#define SWRITE(b, i) do { *(bf16x8*)((char*)V_lds + (b) * SHM_V + vst0) = sr_[i].vs0;          \
    *(bf16x8*)((char*)V_lds + (b) * SHM_V + vst1) = sr_[i].vs1; int kc = sc * 2;               \
    *(bf16x8*)((char*)K_lds + (b) * SHM_K + KSWZ(sr, kc)) = sr_[i].ks0;                       \
    *(bf16x8*)((char*)K_lds + (b) * SHM_K + KSWZ(32 + sr, kc)) = sr_[i].ks1; } while (0)
#define SWAIT() asm volatile("s_waitcnt vmcnt(4)" ::: "memory")
#define RESC(a) do { if (__any((a) < 1.f)) { if (hi == 0) al_l[r32] = (a); asm volatile("s_waitcnt lgkmcnt(0)" ::: "memory"); \
    for (int d = 0; d < 4; ++d) for (int r = 0; r < 16; ++r) o[d][r] *= al_l[crow(r, hi)]; } } while (0)
  f32x16 pA0, pA1, pB0, pB1; float mnA, mnB, alA, alB; bf16x8 pa0, pa1, pa2, pa3; const int NT = seq / KVBLK;
  constexpr int SE = 0, SO = 1;
  SLOAD(SE, 0); asm volatile("s_waitcnt vmcnt(0)" ::: "memory"); SWRITE(0, SE); __syncthreads();
  qkt(pA0, pA1, K_lds, qr, r32, hi); partialSM(pA0, pA1, m_reg, mnA, alA);
  SLOAD(SO, KVBLK); if (2 < NT) SLOAD(SE, 2 * KVBLK);
  SWAIT(); SWRITE(1, SO); __syncthreads();
  for (int j = 1; j + 1 < NT; j += 2) {
    SBAR(); qkt(pB0, pB1, (bf16_t*)((char*)K_lds + SHM_K), qr, r32, hi);
    finishSM(pA0, pA1, alA, l_reg, pa0, pa1, pa2, pa3); SBAR();
    SLOAD(SO, (j + 2) * KVBLK); SBAR();
    pv_d0(o, vb0, pa0, pa1, pa2, pa3); partialSM(pB0, pB1, m_reg, mnB, alB);
    __syncthreads(); SWAIT(); SWRITE(0, SE);
    RESC(alB); __syncthreads();
    SBAR(); qkt(pA0, pA1, K_lds, qr, r32, hi);
    finishSM(pB0, pB1, alB, l_reg, pa0, pa1, pa2, pa3); SBAR();
    if (j + 3 < NT) SLOAD(SE, (j + 3) * KVBLK); SBAR();
    pv_d0(o, vb0 + (int)SHM_V, pa0, pa1, pa2, pa3); partialSM(pA0, pA1, m_reg, mnA, alA);
    __syncthreads(); SWAIT(); SWRITE(1, SO);
    RESC(alA); __syncthreads();
  }
  SBAR(); qkt(pB0, pB1, (bf16_t*)((char*)K_lds + SHM_K), qr, r32, hi);
  finishSM(pA0, pA1, alA, l_reg, pa0, pa1, pa2, pa3); SBAR();
  pv_d0(o, vb0, pa0, pa1, pa2, pa3); partialSM(pB0, pB1, m_reg, mnB, alB);
  __syncthreads(); RESC(alB);
  finishSM(pB0, pB1, alB, l_reg, pa0, pa1, pa2, pa3); SBAR();
  pv_d0(o, vb0 + (int)SHM_V, pa0, pa1, pa2, pa3);
  if (hi == 0) li_l[r32] = l_reg; asm volatile("s_waitcnt lgkmcnt(0)" ::: "memory");
  float rli[16];
#pragma unroll
  for (int r = 0; r < 16; ++r) rli[r] = __builtin_amdgcn_rcpf(li_l[crow(r, hi)]);
  bf16_t* Ow = Ob + (long)(wid * QBLK) * ldo;
#pragma unroll
  for (int r = 0; r < 16; ++r) { int orow = crow(r, hi);
    for (int d0 = 0; d0 < 4; ++d0) Ow[(long)orow * ldo + d0 * 32 + r32] = (bf16_t)(cvt_pk_bf16(o[d0][r] * rli[r], 0.f) & 0xffffu); }
  __syncthreads();
#undef SLOAD
#undef SWRITE
#undef SWAIT
#undef RESC
}
#undef KSWZ
#undef SBAR
}

struct Args { const float* in[22]; float* out; unsigned char* ws; };
enum { I_X = 0, I_C, I_CTX, I_CCTX, I_ADAW, I_ADAB, I_LNG, I_LNB, I_GQKV, I_GQN, I_GKN, I_GWO, I_DQKV, I_DLAM, I_DSUB, I_DWO, I_FW, I_FB, I_WUP, I_CW, I_CB, I_WDN };

struct Frame {
    LAS unsigned char* lds;
    int vcu, G;
};


typedef const float* cfptr_t;
typedef __attribute__((address_space(4))) const unsigned char* kseg_t;
__device__ __forceinline__ kseg_t kseg() { kseg_t ka = (kseg_t)__builtin_amdgcn_kernarg_segment_ptr(); asm volatile("" : "+s"(ka)); return ka; }
__device__ __forceinline__ const float* KIN(int k) { return *(const __attribute__((address_space(4))) cfptr_t*)(kseg() + 8 * k); }
__device__ __forceinline__ float* KOUT() { return *(float* const __attribute__((address_space(4)))*)(kseg() + 8 * 22); }
__device__ __forceinline__ unsigned char* KWS() { return *(unsigned char* const __attribute__((address_space(4)))*)(kseg() + 8 * 23); }
#define WSP(T, OFF) ((T*)(KWS() + (OFF)))

__device__ __forceinline__ void transpose_item(const float* W, int K, int N, bf16_t* WT, LAS float* scr, int item, int lane) {
    const int nblk = N / 64, kb = item / nblk, nb = item % nblk, k0 = 64 * kb, n0 = 64 * nb;
    const int lr = lane >> 4, lc = (lane & 15) * 4;
#pragma unroll
    for (int i = 0; i < 16; ++i) { const int kk = 4 * i + lr; const f32x4 v = *(const GAS f32x4*)(W + (size_t)(k0 + kk) * N + n0 + lc);
        LAS float* s = scr + kk * 65 + lc; s[0] = v[0]; s[1] = v[1]; s[2] = v[2]; s[3] = v[3]; }
    LDS_WAIT(); asm volatile("" ::: "memory");
    const int c = lane & 7;
#pragma unroll
    for (int j = 0; j < 8; ++j) { const int n = (lane >> 3) + 8 * j; const LAS float* s = scr + (8 * c) * 65 + n;
        u32x4 o; o.x = cvt_pk_bf16(s[0 * 65], s[1 * 65]); o.y = cvt_pk_bf16(s[2 * 65], s[3 * 65]); o.z = cvt_pk_bf16(s[4 * 65], s[5 * 65]); o.w = cvt_pk_bf16(s[6 * 65], s[7 * 65]);
        *(GAS u32x4*)(WT + (size_t)(n0 + n) * K + k0 + 8 * c) = o; }
    LDS_WAIT(); asm volatile("" ::: "memory");
}
__device__ __forceinline__ float silu_f(float x) { return x / (1.f + __expf(-x)); }

__global__ void __launch_bounds__(NWAVES * 64, 2) hybrid_fwd(Args args) {
    extern __shared__ __attribute__((aligned(16))) unsigned char lds[];
    Frame F;
    F.lds = (LAS unsigned char*)lds;
    F.G = gridDim.x; { const int bx = blockIdx.x; F.vcu = (F.G % 8 == 0) ? (bx % 8) * (F.G / 8) + bx / 8 : bx; }
    volatile LAS unsigned* MISC = (volatile LAS unsigned*)(F.lds + MISC_OFF);
    for (int u = threadIdx.x; u < (LDS_BYTES - LDSCTL_OFF) / 4; u += NWAVES * 64) ((LAS unsigned*)(F.lds + LDSCTL_OFF))[u] = 0u;
    __syncthreads();
    (void)xcd_barrier_post((unsigned*)(KWS() + WS_CTL) + CW_BAR, MISC + 8);
#if PROBE_TS
    int nst_ = 1;
    if (blockIdx.x == 0 && threadIdx.x == 0) ((unsigned long long*)(KWS() + WS_CTL + 65536))[0] = __builtin_amdgcn_s_memrealtime();
#define STAMP() do { if (blockIdx.x == 0 && threadIdx.x == 0) ((unsigned long long*)(KWS() + WS_CTL + 65536))[nst_] = __builtin_amdgcn_s_memrealtime(); ++nst_; } while (0)
#else
#define STAMP() do {} while (0)
#endif
#define GRID_BAR() do { XcdBarrier b_; b_.bar = (unsigned*)(KWS() + WS_CTL) + CW_BAR; b_.x = xb_xcc_id(); b_.st = (volatile LAS unsigned*)(F.lds + MISC_OFF) + 8; xcd_barrier(b_); STAMP(); } while (0)
    const int NGW = F.G * NWAVES, NGT = F.G * NWAVES * 64;
#define PHASE_IDS const int tid_ = opq_tid(); const int lane_ = tid_ & 63; const int wave_ = __builtin_amdgcn_readfirstlane(tid_ >> 6); const int gw = F.vcu * NWAVES + wave_; const int gt = F.vcu * (NWAVES * 64) + tid_; (void)gw; (void)gt; (void)lane_;

#define MOD WSP(float, WS_MOD)
#define X WSP(float, WS_X)
#define OUTF WSP(float, WS_OUTF)
#define ABF WSP(bf16_t, WS_ABF)
#define QKV WSP(bf16_t, WS_QKV)
#define OATT WSP(bf16_t, WS_OATT)
#define OBF WSP(bf16_t, WS_OBF)
#define UB WSP(bf16_t, WS_U)
#define ACT WSP(bf16_t, WS_ACT)
#define ZT WSP(bf16_t, WS_ZT)
#define TBUF WSP(bf16_t, WS_T)
#define WAT WSP(bf16_t, WS_WAT)
#define WBT WSP(bf16_t, WS_WBT)
#define A2C WSP(bf16_t, WS_A2C)
#define CS WSP(bf16_t, WS_CS)
#define PART WSP(float, WS_PART)
#define ROPEC WSP(float, WS_ROPE)
#define ROPES (WSP(float, WS_ROPE) + SEQ * 64)

    {
        PHASE_IDS
        LAS float* scr = (LAS float*)(F.lds + wave_ * 16640);
        constexpr int I_QG = (DM / 64) * (3072 / 64), I_SQ = (DM / 64) * (DM / 64), I_QD = (DM / 64) * (6144 / 64), I_UP = (DM / 64) * (NUP / 64), I_DN = (DFF / 64) * (DM / 64);
        constexpr int NIT = 2 * I_QG + 2 * I_SQ + I_QD + I_SQ + I_SQ + 4 * I_UP + 4 * I_DN;
        for (int it = gw; it < NIT; it += NGW) {
            int r = it;
            if (r < 2 * I_QG) { const int j = r / I_QG; transpose_item(KIN(I_GQKV) + (size_t)j * DM * 3072, DM, 3072, (bf16_t*)(KWS() + WS_WQKV_G) + (size_t)j * 3072 * DM, scr, r % I_QG, lane_); continue; } r -= 2 * I_QG;
            if (r < 2 * I_SQ) { const int j = r / I_SQ; transpose_item(KIN(I_GWO) + (size_t)j * DM * DM, DM, DM, (bf16_t*)(KWS() + WS_WO_G) + (size_t)j * DM * DM, scr, r % I_SQ, lane_); continue; } r -= 2 * I_SQ;
            if (r < I_QD) { transpose_item(KIN(I_DQKV), DM, 6144, (bf16_t*)(KWS() + WS_WQKV_D), scr, r, lane_); continue; } r -= I_QD;
            if (r < I_SQ) { transpose_item(KIN(I_DWO), DM, DM, (bf16_t*)(KWS() + WS_WO_D), scr, r, lane_); continue; } r -= I_SQ;
            if (r < I_SQ) { transpose_item(KIN(I_FW), DM, DM, (bf16_t*)(KWS() + WS_WF), scr, r, lane_); continue; } r -= I_SQ;
            if (r < 4 * I_UP) { const int j = r / I_UP; transpose_item(KIN(I_WUP) + (size_t)j * DM * NUP, DM, NUP, (bf16_t*)(KWS() + WS_WUP) + (size_t)j * NUP * DM, scr, r % I_UP, lane_); continue; } r -= 4 * I_UP;
            { const int j = r / I_DN; transpose_item(KIN(I_WDN) + (size_t)j * DFF * DM, DFF, DM, (bf16_t*)(KWS() + WS_WDN) + (size_t)j * DM * DFF, scr, r % I_DN, lane_); }
        }
        {
            float* MODP = (float*)(KWS() + WS_MODP);
            for (int it = gw; it < DEPTH * 32 * 48; it += NGW) {
                const int nc = it % 48, kc = (it / 48) % 32, layer = it / (48 * 32);
                const float sl = silu_f(KIN(I_C)[kc * 64 + lane_]), sc = silu_f(KIN(I_CCTX)[kc * 64 + lane_]);
                const float* w = KIN(I_ADAW) + ((size_t)layer * DM + kc * 64) * NMOD + nc * 256 + lane_ * 4;
                f32x4 al = {0.f, 0.f, 0.f, 0.f}, ac = {0.f, 0.f, 0.f, 0.f};
#pragma unroll 16
                for (int k = 0; k < 64; ++k) { const f32x4 wv = *(const GAS f32x4*)(w + (size_t)k * NMOD);
                    const float a = __shfl(sl, k), b = __shfl(sc, k); al += wv * a; ac += wv * b; }
                float* o = MODP + ((size_t)(layer * 32 + kc) * 2) * NMOD + nc * 256 + lane_ * 4;
                *(GAS f32x4*)o = al; *(GAS f32x4*)(o + NMOD) = ac;
            }
        }
        for (int e = gt; e < SEQ * 64; e += NGT) { const int pos = e >> 6, a = e & 63, j = a & 31; const float p = (float)(a < 32 ? (pos >> 6) : (pos & 63));
            const float inv = powf(10000.f, -(float)j / 32.f); float s, c; sincosf(p * inv, &s, &c); ROPEC[e] = c; ROPES[e] = s; }
#if EN_FNET
        for (int e = gt; e < 1024 * 512; e += NGT) { const int c = e & 511, m = (e >> 9) & 511, trig = e >> 18; float s, co; sincospif((float)((m * c) & 511) * (1.f / 256.f), &s, &co);
            const float v = (trig ? s : co) * 0.044194173824159216f; CS[e] = (bf16_t)(cvt_pk_bf16(v, 0.f) & 0xffffu); }
        __syncthreads();
        { LAS float* ct = (LAS float*)F.lds;
          for (int j = tid_; j < 8192; j += NWAVES * 64) { float s, c; sincospif((float)j * (1.f / 4096.f), &s, &c); ct[j] = c; }
          __syncthreads();
          for (int e8 = gt; e8 < 4 * 256 * 128; e8 += NGT) { const int kap0 = (e8 & 127) * 8, j = (e8 >> 7) & 255, kb = e8 >> 15;
              const int k1 = kb * 16 + (j >> 4), ri = (j >> 3) & 1, l2o = j & 7, l2i = kap0 >> 7, trig = (kap0 >> 6) & 1, l1b = kap0 & 63;
              const int ph = (ri == 0) ? (trig ? 2048 : 0) : (trig ? 4096 : 2048);
              float v[8];
#pragma unroll
              for (int t = 0; t < 8; ++t) v[t] = (l2i == l2o) ? ct[(((k1 * (l1b + t)) & 63) * 128 + ph) & 8191] * 0.125f : 0.f;
              u32x4 o; o.x = cvt_pk_bf16(v[0], v[1]); o.y = cvt_pk_bf16(v[2], v[3]); o.z = cvt_pk_bf16(v[4], v[5]); o.w = cvt_pk_bf16(v[6], v[7]);
              *(GAS u32x4*)(WAT + (size_t)e8 * 8) = o; }
          for (int e8 = gt; e8 < 32 * 256 * 64; e8 += NGT) { const int kap0 = (e8 & 63) * 8, r = (e8 >> 6) & 255, pp = e8 >> 14;
              const int e = r >> 7, k = 2 * pp + e + 64 * (r & 127), ei = kap0 >> 8, ri = (kap0 >> 7) & 1, l2b = kap0 & 127;
              const int ph = ri ? 6144 : 0;
              float v[8];
#pragma unroll
              for (int t = 0; t < 8; ++t) v[t] = (ei == e) ? ct[(k * (l2b + t) + ph) & 8191] * 0.08838834764831845f : 0.f;
              u32x4 o; o.x = cvt_pk_bf16(v[0], v[1]); o.y = cvt_pk_bf16(v[2], v[3]); o.z = cvt_pk_bf16(v[4], v[5]); o.w = cvt_pk_bf16(v[6], v[7]);
              *(GAS u32x4*)(WBT + (size_t)e8 * 8) = o; }
          for (int e8 = gt; e8 < CTXL * (2 * CTXL / 8); e8 += NGT) { const int k = e8 >> 6, l0 = (e8 & 63) * 8; const int ph = l0 >= CTXL ? 2048 : 0, lb = l0 & (CTXL - 1);
              float v[8];
#pragma unroll
              for (int t = 0; t < 8; ++t) v[t] = ct[(32 * k * (lb + t) + ph) & 8191] * 0.0625f;
              u32x4 o; o.x = cvt_pk_bf16(v[0], v[1]); o.y = cvt_pk_bf16(v[2], v[3]); o.z = cvt_pk_bf16(v[4], v[5]); o.w = cvt_pk_bf16(v[6], v[7]);
              *(GAS u32x4*)(A2C + (size_t)k * 512 + l0) = o; }
          __syncthreads(); }
#endif
    }
    GRID_BAR();
    {
        PHASE_IDS
        const float* MODP = (const float*)(KWS() + WS_MODP);
        for (int e = gt; e < DEPTH * 2 * NMOD; e += NGT) { const int n = e % NMOD, v = (e / NMOD) & 1, layer = e / (2 * NMOD);
            float s = KIN(I_ADAB)[layer * NMOD + n];
#pragma unroll 8
            for (int kc = 0; kc < 32; ++kc) s += MODP[((size_t)(layer * 32 + kc) * 2 + v) * NMOD + n];
            MOD[e] = s; }
    }
    GRID_BAR();
    { PHASE_IDS
    for (int row = gw; row < MROWS; row += NGW) {
        const int isc = row >= SEQ; const float* xin = isc ? KIN(I_CTX) + (size_t)(row - SEQ) * DM : KIN(I_X) + (size_t)row * DM;
        const float* mod = MOD + (size_t)isc * NMOD;
#pragma unroll
        for (int j = 0; j < 8; ++j) { const int c = 4 * lane_ + 256 * j; const f32x4 xv = *(const GAS f32x4*)(xin + c), sh = *(const GAS f32x4*)(mod + c), sc = *(const GAS f32x4*)(mod + DM + c);
            const f32x4 a = xv * (sc + 1.f) + sh; u32x2 w; w.x = cvt_pk_bf16(a[0], a[1]); w.y = cvt_pk_bf16(a[2], a[3]); *(GAS u32x2*)(ABF + (size_t)row * DM + c) = w; }
    } }
    GRID_BAR();

#pragma unroll 1
    for (int layer = 0; layer < DEPTH; ++layer) {
        const int kind = layer % 3, jidx = layer / 3;
        bool have_o = false;
        if ((kind == 0 && EN_GQA) || (kind == 1 && EN_DIFF) || (kind == 2 && EN_FNET)) {
            have_o = true;
            for (int call = 0; call < (kind == 2 ? 2 : 1); ++call) {
                pg8::Sched S; S.G = F.G; S.c = (int)blockIdx.x; S.bmap = 0; S.ks = 0; S.nsplit = 0;
                pg8::EpiBf16 E; E.cmode = 0; E.rmode = 0;
                if (kind == 0) { S.A = (const char*)ABF; S.B = (const char*)(KWS() + WS_WQKV_G) + (size_t)jidx * 3072 * DM * 2; S.lda = DM; S.ldb = DM; S.nM = MROWS / 256; S.nN = 3072 / 256; S.nt = DM / 64; S.mode = 0; E.O = QKV; E.ldc = 3072; }
                else if (kind == 1) { S.A = (const char*)ABF; S.B = (const char*)(KWS() + WS_WQKV_D); S.lda = DM; S.ldb = DM; S.nM = MROWS / 256; S.nN = 6144 / 256; S.nt = DM / 64; S.mode = 0; E.O = QKV; E.ldc = 6144; }
                else if (call == 0) { S.A = (const char*)CS; S.B = (const char*)ABF; S.lda = 512; S.ldb = DM; S.nM = 16; S.nN = 32; S.nt = 8; S.mode = 1; S.bmap = 1; E.O = ZT; E.ldc = ZLD; E.cmode = 1; }
                else { S.A = (const char*)CS; S.B = (const char*)ABF; S.lda = 512; S.ldb = DM; S.nM = 16; S.nN = 1; S.nt = 8; S.mode = 6; E.O = ZT; E.ldc = ZLD; }
                pg8::gemm_phase<pg8::EpiBf16, true>(F.lds, S, E);
            }
            GRID_BAR();
            if (kind != 2) {
                PHASE_IDS
                const int ldq = kind == 0 ? 3072 : 6144, ngrp = kind == 0 ? 5 : 8;
                const int l16 = lane_ & 15, hq = lane_ >> 4;
                const int half = l16 >> 3, jb = 8 * (l16 & 3); const float sgn = (l16 & 4) ? 1.f : -1.f;
                for (int row = gw; row < MROWS; row += NGW) {
                    if (kind == 1 && row >= SEQ) continue;
                    for (int g = 0; g < ngrp; ++g) {
                        const int hv = g * 4 + hq;
                        bf16_t* p = QKV + (size_t)row * ldq + hv * 128 + l16 * 8;
                        const u32x4 raw = *(const GAS u32x4*)p;
                        float v[8] = {bf_lo(raw.x), bf_hi(raw.x), bf_lo(raw.y), bf_hi(raw.y), bf_lo(raw.z), bf_hi(raw.z), bf_lo(raw.w), bf_hi(raw.w)};
                        if (kind == 0) {
                            float ss = 0.f;
#pragma unroll
                            for (int t = 0; t < 8; ++t) ss += v[t] * v[t];
                            ss += __shfl_xor(ss, 1); ss += __shfl_xor(ss, 2); ss += __shfl_xor(ss, 4); ss += __shfl_xor(ss, 8);
                            const float inv = rsqrtf(ss * (1.f / 128.f) + LN_EPS);
                            const float* gn = (hv < 16 ? KIN(I_GQN) : KIN(I_GKN)) + jidx * 128 + l16 * 8;
                            const f32x4 g0 = *(const GAS f32x4*)gn, g1 = *(const GAS f32x4*)(gn + 4);
#pragma unroll
                            for (int t = 0; t < 4; ++t) { v[t] *= inv * g0[t]; v[4 + t] *= inv * g1[t]; }
                        }
                        if (row < SEQ) {
                            const float* cp = ROPEC + (size_t)row * 64 + half * 32 + jb; const float* sp = ROPES + (size_t)row * 64 + half * 32 + jb;
                            const f32x4 c0 = *(const GAS f32x4*)cp, c1 = *(const GAS f32x4*)(cp + 4), s0 = *(const GAS f32x4*)sp, s1 = *(const GAS f32x4*)(sp + 4);
#pragma unroll
                            for (int t = 0; t < 8; ++t) { const float pr = __shfl_xor(v[t], 4); const float c = t < 4 ? c0[t & 3] : c1[t & 3], s = t < 4 ? s0[t & 3] : s1[t & 3]; v[t] = v[t] * c + sgn * pr * s; }
                        }
#ifdef PROBE_UNIFORM_GQA
                        if (kind == 0 && hv < 16) { for (int t = 0; t < 8; ++t) v[t] = 0.f; }
#endif
                        u32x4 w; w.x = cvt_pk_bf16(v[0], v[1]); w.y = cvt_pk_bf16(v[2], v[3]); w.z = cvt_pk_bf16(v[4], v[5]); w.w = cvt_pk_bf16(v[6], v[7]);
                        *(GAS u32x4*)p = w;
                    }
                }
                GRID_BAR();
                {
                    const int nprob = kind == 0 ? 16 : 32, NU = nprob * (SEQ / 256);
                    const bool lastl = (layer == DEPTH - 1);
                    for (int i = 0;; ++i) {
                        const int L = i * F.G + F.vcu; int p, row0, seq, krow0;
                        if (L < NU) { p = L / (SEQ / 256); row0 = (L % (SEQ / 256)) * 256; seq = MROWS; krow0 = 0; }
                        else if (L < NU + nprob && !lastl) { p = L - NU; row0 = SEQ; seq = CTXL; krow0 = SEQ; }
                        else break;
                        const bf16_t *Qp, *Kp, *Vp; bf16_t* Op;
                        if (kind == 0) { Qp = QKV + (size_t)row0 * ldq + p * 128; Kp = QKV + (size_t)krow0 * ldq + 2048 + (p >> 2) * 128; Vp = Kp + 512; Op = OATT + (size_t)row0 * DM + p * 128; }
                        else { const int e = p & 1, c = (p >> 1) & 1, h = p >> 2, hh = 2 * h + c;
                            Qp = QKV + (size_t)row0 * ldq + hh * 128; Kp = QKV + (size_t)krow0 * ldq + 2048 + hh * 128; Vp = QKV + (size_t)krow0 * ldq + 4096 + h * 256 + e * 128;
                            Op = OATT + (size_t)c * MROWS * DM + (size_t)row0 * DM + h * 256 + e * 128; }
                        att::attn_unit(Qp, ldq, Kp, Vp, ldq, Op, DM, seq, (char*)lds);
                    }
                }
                GRID_BAR();
                if (kind == 1) {
                    PHASE_IDS
                    const float* lp = KIN(I_DLAM) + jidx * 512;
                    const float d1 = wave_sum(lp[lane_] * lp[128 + lane_] + lp[64 + lane_] * lp[192 + lane_]);
                    const float d2 = wave_sum(lp[256 + lane_] * lp[384 + lane_] + lp[320 + lane_] * lp[448 + lane_]);
                    const float lam_init = 0.8f - 0.6f * expf(-0.3f * (float)layer);
                    const float lam = expf(d1) - expf(d2) + lam_init, post = 1.f - lam_init;
                    const int l32 = lane_ & 31, h2 = lane_ >> 5;
                    const float* sg = KIN(I_DSUB) + jidx * 256 + l32 * 8; const f32x4 g0 = *(const GAS f32x4*)sg, g1 = *(const GAS f32x4*)(sg + 4);
                    for (int row = gw; row < MROWS; row += NGW)
                        for (int g = 0; g < 4; ++g) { const size_t off = (size_t)row * DM + (g * 2 + h2) * 256 + l32 * 8;
                            const u32x4 a = *(const GAS u32x4*)(OATT + off), b = *(const GAS u32x4*)(OATT + (size_t)MROWS * DM + off);
                            float v[8] = {bf_lo(a.x) - lam * bf_lo(b.x), bf_hi(a.x) - lam * bf_hi(b.x), bf_lo(a.y) - lam * bf_lo(b.y), bf_hi(a.y) - lam * bf_hi(b.y),
                                          bf_lo(a.z) - lam * bf_lo(b.z), bf_hi(a.z) - lam * bf_hi(b.z), bf_lo(a.w) - lam * bf_lo(b.w), bf_hi(a.w) - lam * bf_hi(b.w)};
                            float ss = 0.f;
#pragma unroll
                            for (int t = 0; t < 8; ++t) ss += v[t] * v[t];
                            ss += __shfl_xor(ss, 1); ss += __shfl_xor(ss, 2); ss += __shfl_xor(ss, 4); ss += __shfl_xor(ss, 8); ss += __shfl_xor(ss, 16);
                            const float inv = rsqrtf(ss * (1.f / 256.f) + LN_EPS) * post;
#pragma unroll
                            for (int t = 0; t < 4; ++t) { v[t] *= inv * g0[t]; v[4 + t] *= inv * g1[t]; }
                            u32x4 w; w.x = cvt_pk_bf16(v[0], v[1]); w.y = cvt_pk_bf16(v[2], v[3]); w.z = cvt_pk_bf16(v[4], v[5]); w.w = cvt_pk_bf16(v[6], v[7]);
                            *(GAS u32x4*)(OBF + off) = w; }
                    GRID_BAR();
                }
            } else {
                for (int call = 0; call < 3; ++call) {
                    pg8::Sched S; S.G = F.G; S.c = (int)blockIdx.x; S.bmap = 0; S.ks = 0; S.nsplit = 0;
                    pg8::EpiBf16 E; E.cmode = 0; E.rmode = 0;
                    if (call == 0) { S.A = (const char*)ZT; S.B = (const char*)WAT; S.lda = ZLD; S.ldb = 1024; S.nM = 8; S.nN = 64; S.nt = 16; S.mode = 4; E.O = TBUF; E.ldc = TLD; E.cmode = 2; }
                    else if (call == 1) { S.A = (const char*)A2C; S.B = (const char*)ZT; S.lda = 512; S.ldb = ZLD; S.nM = 8; S.nN = 1; S.nt = 8; S.mode = 7; E.O = OBF; E.ldc = DM; }
                    else { GRID_BAR(); S.A = (const char*)WBT; S.B = (const char*)TBUF; S.lda = 512; S.ldb = TLD; S.nM = 32; S.nN = 8; S.nt = 8; S.mode = 5; E.O = OBF; E.ldc = DM; E.rmode = 1; }
                    pg8::gemm_phase<pg8::EpiBf16, true>(F.lds, S, E);
                }
                GRID_BAR();
            }
            {
                pg8::Sched S; S.G = F.G; S.c = (int)blockIdx.x; S.lda = DM; S.ldb = DM; S.nM = MROWS / 256; S.nN = DM / 256; S.nt = DM / 64; S.mode = 3; S.bmap = 0; S.ks = 8; S.nsplit = (layer == DEPTH - 1) ? 0 : NSPLIT_WO;
                pg8::EpiF32 E; E.C = OUTF; E.ldc = DM; E.bias = nullptr; E.Cpart = PART;
                if (kind == 0) { S.A = (const char*)OATT; S.B = (const char*)(KWS() + WS_WO_G) + (size_t)jidx * DM * DM * 2; }
                else if (kind == 1) { S.A = (const char*)OBF; S.B = (const char*)(KWS() + WS_WO_D); }
                else { S.A = (const char*)OBF; S.B = (const char*)(KWS() + WS_WF); E.bias = KIN(I_FB) + jidx * DM; }
                pg8::gemm_phase<pg8::EpiF32, true>(F.lds, S, E);
            }
            GRID_BAR();
        }
#define LN_PHASE(WHICH, USE_O) do { PHASE_IDS \
        const float* lng = KIN(I_LNG) + (size_t)(layer * 2 + (WHICH)) * DM; const float* lnb = KIN(I_LNB) + (size_t)(layer * 2 + (WHICH)) * DM; \
        const bool fin = (layer == DEPTH - 1) && (WHICH) == 1; \
        for (int row = gw; row < MROWS; row += NGW) { \
            const int isc = row >= SEQ; if (fin && isc) continue; \
            const float* xin = (layer == 0 && (WHICH) == 0) ? (isc ? KIN(I_CTX) + (size_t)(row - SEQ) * DM : KIN(I_X) + (size_t)row * DM) : X + (size_t)row * DM; \
            const float* mod = MOD + (size_t)(layer * 2 + isc) * NMOD; const float* gate = mod + ((WHICH) ? 5 : 2) * DM; \
            const float* nsh = (WHICH) ? MOD + (size_t)(((layer + 1) & 3) * 2 + isc) * NMOD : mod + 3 * DM; const float* nsc = nsh + DM; \
            f32x4 v[8]; float s = 0.f; \
            _Pragma("unroll") for (int j = 0; j < 8; ++j) { const int c = 4 * lane_ + 256 * j; v[j] = *(const GAS f32x4*)(xin + c) * ALPHA_RES; \
                if (USE_O) { f32x4 ov; if (isc) { ov = (f32x4){0.f, 0.f, 0.f, 0.f}; for (int sp = 0; sp < ((WHICH) ? NSPLIT_DN : NSPLIT_WO); ++sp) ov += *(const GAS f32x4*)(PART + ((size_t)sp * 256 + (row - SEQ)) * DM + c); } \
                    else ov = *(const GAS f32x4*)(OUTF + (size_t)row * DM + c); v[j] += *(const GAS f32x4*)(gate + c) * ov; } \
                s += (v[j][0] + v[j][1]) + (v[j][2] + v[j][3]); } \
            const float mean = wave_sum(s) * (1.f / DM); float s2 = 0.f; \
            _Pragma("unroll") for (int j = 0; j < 8; ++j) { v[j] = v[j] - mean; s2 += (v[j][0] * v[j][0] + v[j][1] * v[j][1]) + (v[j][2] * v[j][2] + v[j][3] * v[j][3]); } \
            const float rstd = rsqrtf(wave_sum(s2) * (1.f / DM) + LN_EPS); \
            _Pragma("unroll") for (int j = 0; j < 8; ++j) { const int c = 4 * lane_ + 256 * j; \
                const f32x4 y = v[j] * rstd * *(const GAS f32x4*)(lng + c) + *(const GAS f32x4*)(lnb + c); \
                if (fin) { *(GAS f32x4*)(KOUT() + (size_t)row * DM + c) = y; } \
                else { *(GAS f32x4*)(X + (size_t)row * DM + c) = y; \
                    const f32x4 a = y * (*(const GAS f32x4*)(nsc + c) + 1.f) + *(const GAS f32x4*)(nsh + c); \
                    u32x2 w; w.x = cvt_pk_bf16(a[0], a[1]); w.y = cvt_pk_bf16(a[2], a[3]); *(GAS u32x2*)(ABF + (size_t)row * DM + c) = w; } } \
        } } while (0)
        if (have_o) LN_PHASE(0, true); else LN_PHASE(0, false);
        GRID_BAR();
#if EN_FFN
        {
            pg8::Sched S; S.G = F.G; S.c = (int)blockIdx.x; S.A = (const char*)ABF; S.B = (const char*)(KWS() + WS_WUP) + (size_t)layer * NUP * DM * 2; S.lda = DM; S.ldb = DM; S.nM = MROWS / 256; S.nN = NUP / 256; S.nt = DM / 64; S.mode = 0; S.bmap = 0; S.ks = 0; S.nsplit = 0;
            pg8::EpiBf16 E; E.O = UB; E.ldc = NUP; E.cmode = 0; E.rmode = 0;
            pg8::gemm_phase<pg8::EpiBf16, true>(F.lds, S, E);
        }
        GRID_BAR();
        {
            PHASE_IDS
            const float* cw = KIN(I_CW) + (size_t)layer * 3 * NUP; const float* cb = KIN(I_CB) + (size_t)layer * NUP;
            for (int it = gt; it < (MROWS / 16) * (DFF / 8); it += NGT) {
                const int cg = it % (DFF / 8), rc = it / (DFF / 8), c0 = cg * 8, r0 = rc * 16;
                float wv[3][8], wg[3][8], bv[8], bg[8];
#pragma unroll
                for (int t = 0; t < 3; ++t)
#pragma unroll
                    for (int h = 0; h < 2; ++h) { const f32x4 a = *(const GAS f32x4*)(cw + (size_t)t * NUP + c0 + 4 * h), b = *(const GAS f32x4*)(cw + (size_t)t * NUP + DFF + c0 + 4 * h);
#pragma unroll
                        for (int q = 0; q < 4; ++q) { wv[t][4 * h + q] = a[q]; wg[t][4 * h + q] = b[q]; } }
#pragma unroll
                for (int h = 0; h < 2; ++h) { const f32x4 a = *(const GAS f32x4*)(cb + c0 + 4 * h), b = *(const GAS f32x4*)(cb + DFF + c0 + 4 * h);
#pragma unroll
                    for (int q = 0; q < 4; ++q) { bv[4 * h + q] = a[q]; bg[4 * h + q] = b[q]; } }
                const bool seg_first = (r0 == 0) || (r0 == SEQ), seg_last = (r0 + 16 == SEQ) || (r0 + 16 == MROWS);
                const bf16_t* up = UB + (size_t)r0 * NUP + c0;
                u32x4 pv = {0u, 0u, 0u, 0u}, pg = {0u, 0u, 0u, 0u};
                if (!seg_first) { pv = *(const GAS u32x4*)(up - NUP); pg = *(const GAS u32x4*)(up - NUP + DFF); }
                u32x4 cv = *(const GAS u32x4*)up, cg4 = *(const GAS u32x4*)(up + DFF);
                for (int r = 0; r < 16; ++r) {
                    u32x4 nv = {0u, 0u, 0u, 0u}, ng = {0u, 0u, 0u, 0u};
                    if (r < 15 || !seg_last) { nv = *(const GAS u32x4*)(up + (size_t)(r + 1) * NUP); ng = *(const GAS u32x4*)(up + (size_t)(r + 1) * NUP + DFF); }
                    float o[8];
#pragma unroll
                    for (int q = 0; q < 4; ++q) {
                        const unsigned a0 = pv[q], a1 = cv[q], a2 = nv[q], b0 = pg[q], b1 = cg4[q], b2 = ng[q];
                        const float v0 = wv[0][2 * q] * bf_lo(a0) + wv[1][2 * q] * bf_lo(a1) + wv[2][2 * q] * bf_lo(a2) + bv[2 * q];
                        const float v1 = wv[0][2 * q + 1] * bf_hi(a0) + wv[1][2 * q + 1] * bf_hi(a1) + wv[2][2 * q + 1] * bf_hi(a2) + bv[2 * q + 1];
                        const float g0 = wg[0][2 * q] * bf_lo(b0) + wg[1][2 * q] * bf_lo(b1) + wg[2][2 * q] * bf_lo(b2) + bg[2 * q];
                        const float g1 = wg[0][2 * q + 1] * bf_hi(b0) + wg[1][2 * q + 1] * bf_hi(b1) + wg[2][2 * q + 1] * bf_hi(b2) + bg[2 * q + 1];
                        o[2 * q] = silu_f(g0) * v0; o[2 * q + 1] = silu_f(g1) * v1;
                    }
                    u32x4 w; w.x = cvt_pk_bf16(o[0], o[1]); w.y = cvt_pk_bf16(o[2], o[3]); w.z = cvt_pk_bf16(o[4], o[5]); w.w = cvt_pk_bf16(o[6], o[7]);
                    *(GAS u32x4*)(ACT + (size_t)(r0 + r) * DFF + c0) = w;
                    pv = cv; pg = cg4; cv = nv; cg4 = ng;
                }
            }
        }
        GRID_BAR();
        {
            pg8::Sched S; S.G = F.G; S.c = (int)blockIdx.x; S.A = (const char*)ACT; S.B = (const char*)(KWS() + WS_WDN) + (size_t)layer * DM * DFF * 2; S.lda = DFF; S.ldb = DFF; S.nM = MROWS / 256; S.nN = DM / 256; S.nt = DFF / 64; S.mode = 3; S.bmap = 0; S.ks = 8; S.nsplit = (layer == DEPTH - 1) ? 0 : NSPLIT_DN;
            pg8::EpiF32 E; E.C = OUTF; E.ldc = DM; E.bias = nullptr; E.Cpart = PART;
            pg8::gemm_phase<pg8::EpiF32, true>(F.lds, S, E);
        }
        GRID_BAR();
        LN_PHASE(1, true);
#else
        LN_PHASE(1, false);
#endif
        if (layer != DEPTH - 1) GRID_BAR();
    }
#if PROBE_TS
    GRID_BAR();
    { const unsigned long long* ts = (const unsigned long long*)(KWS() + WS_CTL + 65536);
      const float v1 = (float)(ts[TS_I1 + 1] - ts[TS_I1]) * 0.01f, v2 = (float)(ts[TS_I2 + 1] - ts[TS_I2]) * 0.01f;
      float* o = KOUT(); const int gt0 = (int)blockIdx.x * 512 + (int)threadIdx.x;
      for (int e = gt0; e < SEQ * DM; e += (int)gridDim.x * 512) o[e] = (e == 0) ? 1000.f * v2 : v1; }
#endif
#undef LN_PHASE
#undef GRID_BAR
}

extern "C" void kernel_launch(void* const* d_in, const int* in_sizes, int n_in, void* d_out, int out_size, void* d_ws, size_t ws_size, hipStream_t stream) {
    static int grid = 0;
    if (grid == 0) {
        if (n_in != 22 || in_sizes[0] != SEQ * DM || out_size != SEQ * DM || ws_size < WS_END) {
            fprintf(stderr, "kernel_launch: unexpected shapes: n_in %d in0 %d out %d ws %zu (need >= %zu)\n", n_in, n_in > 0 ? in_sizes[0] : -1, out_size, ws_size, (size_t)WS_END); grid = -1; return; }
        int dev = 0, cus = 0, per_cu = 0;
        if (hipGetDevice(&dev) != hipSuccess || hipDeviceGetAttribute(&cus, hipDeviceAttributeMultiprocessorCount, dev) != hipSuccess) { grid = -1; return; }
        if (hipFuncSetAttribute((const void*)hybrid_fwd, hipFuncAttributeMaxDynamicSharedMemorySize, LDS_BYTES) != hipSuccess) { fprintf(stderr, "kernel_launch: hipFuncSetAttribute failed\n"); grid = -1; return; }
        if (hipOccupancyMaxActiveBlocksPerMultiprocessor(&per_cu, (const void*)hybrid_fwd, NWAVES * 64, LDS_BYTES) != hipSuccess || per_cu < 1)
            fprintf(stderr, "kernel_launch: note: occupancy query reports %d workgroups per CU\n", per_cu);
        (void)hipGetLastError();
        grid = cus;
        if (grid != 256) fprintf(stderr, "kernel_launch: note: %d CUs\n", grid);
    }
    if (grid < 0) return;
    if (hipMemsetAsync((char*)d_ws + WS_CTL, 0, CTL_ZERO_BYTES, stream) != hipSuccess) { fprintf(stderr, "kernel_launch: memset failed\n"); return; }
    Args a{};
    for (int i = 0; i < 22; ++i) a.in[i] = (const float*)d_in[i];
    a.out = (float*)d_out; a.ws = (unsigned char*)d_ws;
    hipLaunchKernelGGL(hybrid_fwd, dim3(grid), dim3(NWAVES * 64), LDS_BYTES, stream, a);
    const hipError_t le = hipPeekAtLastError();
    if (le != hipSuccess) fprintf(stderr, "kernel_launch: launch failed: %s\n", hipGetErrorName(le));
}
```
